# Optimizing an MI355X kernel written in HIP

```python
import jax, jax.numpy as jnp
from jax import lax
import numpy as np

D_MODEL = 1024
BATCH = 8
SEQ = 4096
DEPTH = 2

N_MIXERS = 2
D_TOK = 3 * D_MODEL // 4
D_MEM = D_MODEL - D_TOK
HG_EXPAND = 128
HG_HEADS = D_TOK // HG_EXPAND
HG_VDIM = D_TOK // HG_HEADS
HG_CHUNK = 64
GM_CHUNK = 128
GM_GROUPS = 6
GM_GDIM = D_TOK // GM_GROUPS
MEM_LEN = 256
MEM_HEADS = 4
MEM_HDIM = D_MEM // MEM_HEADS
D_FF = -(-8 * D_MODEL // (3 * 256)) * 256
N_A = (DEPTH + 1) // 2
N_B = DEPTH // 2
EPS = 1e-6

kernel_name = "hybrid_hgrn2_gmlp_memxattn"


def rmsnorm(x, g):
    xf = x.astype(jnp.float32)
    y = xf * lax.rsqrt(jnp.mean(xf * xf, axis=-1, keepdims=True) + EPS)
    return (y * g.astype(jnp.float32)).astype(x.dtype)


def hgrn2_mix(p, lb):
    B, S, _ = p.shape
    n = S // HG_CHUNK
    q, fz, iv, g = jnp.split(p.astype(jnp.float32), 4, axis=-1)
    lbf = lb.astype(jnp.float32)
    log_f = jnp.log(lbf + (1.0 - lbf) * jax.nn.sigmoid(fz))
    k = -jnp.expm1(log_f)

    def to_chunks(t, d):
        return t.reshape(B, n, HG_CHUNK, HG_HEADS, d).transpose(1, 0, 3, 2, 4)

    qc = to_chunks(q, HG_EXPAND)
    kc = to_chunks(k, HG_EXPAND)
    lc = to_chunks(log_f, HG_EXPAND)
    vc = to_chunks(iv, HG_VDIM)
    causal = jnp.tril(jnp.ones((HG_CHUNK, HG_CHUNK), dtype=bool))[None, None, :, :, None]

    def body(state, inp):
        qb, kb, vb, lg = inp
        b = jnp.cumsum(lg, axis=2)
        inter = jnp.einsum('bhtk,bhkv->bhtv', qb * jnp.exp(b), state)
        diff = b[:, :, :, None, :] - b[:, :, None, :, :]
        decay = jnp.where(causal, jnp.exp(jnp.minimum(diff, 0.0)), 0.0)
        scores = jnp.einsum('bhtk,bhsk,bhtsk->bhts', qb, kb, decay)
        intra = jnp.einsum('bhts,bhsv->bhtv', scores, vb)
        b_last = b[:, :, -1:, :]
        new_state = (jnp.exp(b_last[:, :, 0, :])[..., None] * state
                     + jnp.einsum('bhsk,bhsv->bhkv', kb * jnp.exp(b_last - b), vb))
        return new_state, inter + intra

    s0 = jnp.zeros((B, HG_HEADS, HG_EXPAND, HG_VDIM), jnp.float32)
    _, o = lax.scan(body, s0, (qc, kc, vc, lc))
    o = o.transpose(1, 0, 3, 2, 4).reshape(B, S, HG_HEADS, HG_VDIM)
    o = o * lax.rsqrt(jnp.mean(o * o, axis=-1, keepdims=True) + EPS)
    return o.reshape(B, S, D_TOK) * jax.nn.silu(g)


def gmlp_mix(p, ln_g, ln_b, ws, bs):
    B, S, _ = p.shape
    n = S // GM_CHUNK
    z = jax.nn.gelu(p.astype(jnp.float32), approximate=False)
    u, v = jnp.split(z, 2, axis=-1)
    mu = jnp.mean(v, axis=-1, keepdims=True)
    var = jnp.mean(jnp.square(v - mu), axis=-1, keepdims=True)
    v = (v - mu) * lax.rsqrt(var + EPS) * ln_g.astype(jnp.float32) + ln_b.astype(jnp.float32)
    v = v.reshape(B, n, GM_CHUNK, GM_GROUPS, GM_GDIM)
    w = ws.astype(jnp.float32) * jnp.tril(jnp.ones((GM_CHUNK, GM_CHUNK), jnp.float32))[None]
    sv = jnp.einsum('gts,bnsgc->bntgc', w, v) + bs.astype(jnp.float32).T[None, None, :, :, None]
    return u * sv.reshape(B, S, D_TOK)


def mem_attn(qm, mem, g, w_kv):
    B, S, _ = qm.shape
    m = rmsnorm(mem, g)
    kv = m @ w_kv
    k, v = jnp.split(kv, 2, axis=-1)
    k = k.reshape(B, MEM_LEN, MEM_HEADS, MEM_HDIM)
    v = v.reshape(B, MEM_LEN, MEM_HEADS, MEM_HDIM)
    q = qm.reshape(B, S, MEM_HEADS, MEM_HDIM)
    s = jnp.einsum('bshd,bmhd->bhsm', q, k).astype(jnp.float32) * (MEM_HDIM ** -0.5)
    pr = jax.nn.softmax(s, axis=-1)
    o = jnp.einsum('bhsm,bmhd->bshd', pr, v.astype(jnp.float32))
    return o.reshape(B, S, D_MEM)


def swiglu(h, w_in, w_out):
    a = h @ w_in
    gate, up = jnp.split(a, 2, axis=-1)
    return (jax.nn.silu(gate) * up) @ w_out


def setup_inputs(seed: int = 0) -> dict:
    key = jax.random.key(seed)
    ks = jax.random.split(key, 20)
    f32 = jnp.float32

    def nrm(k, shape, s):
        return jax.random.normal(k, shape, f32) * s

    return {
        "x": nrm(ks[0], (BATCH, SEQ, D_MODEL), 1.0),
        "mem": nrm(ks[1], (BATCH, MEM_LEN, D_MODEL), 1.0),
        "mix_norm": 1.0 + nrm(ks[2], (DEPTH, D_MODEL), 0.02),
        "mem_norm": 1.0 + nrm(ks[3], (DEPTH, D_MODEL), 0.02),
        "w_mem_kv": nrm(ks[4], (DEPTH, D_MODEL, 2 * D_MEM), D_MODEL ** -0.5),
        "w_out": nrm(ks[5], (DEPTH, D_TOK + D_MEM, D_MODEL), (D_TOK + D_MEM) ** -0.5),
        "hg_w_in": nrm(ks[6], (N_A, D_MODEL, 4 * D_TOK + D_MEM), D_MODEL ** -0.5),
        "hg_lb": nrm(ks[7], (DEPTH + 1, D_TOK), 0.5),
        "hg_onorm": 1.0 + nrm(ks[8], (N_A, D_TOK), 0.02),
        "gm_w_in": nrm(ks[9], (N_B, D_MODEL, 2 * D_TOK + D_MEM), D_MODEL ** -0.5),
        "gm_ln_g": 1.0 + nrm(ks[10], (N_B, D_TOK), 0.02),
        "gm_ln_b": nrm(ks[11], (N_B, D_TOK), 0.02),
        "gm_ws": nrm(ks[12], (N_B, GM_GROUPS, GM_CHUNK, GM_CHUNK), GM_CHUNK ** -0.5),
        "gm_bs": 1.0 + nrm(ks[13], (N_B, GM_GROUPS, GM_CHUNK), 0.02),
        "ffn_norm": 1.0 + nrm(ks[14], (DEPTH, D_MODEL), 0.02),
        "w_ffn_in": nrm(ks[15], (DEPTH, D_MODEL, 2 * D_FF), D_MODEL ** -0.5),
        "w_ffn_out": nrm(ks[16], (DEPTH, D_FF, D_MODEL), D_FF ** -0.5),
        "final_norm": 1.0 + nrm(ks[17], (D_MODEL,), 0.02),
    }


def reference(x, mem, mix_norm, mem_norm, w_mem_kv, w_out, hg_w_in, hg_lb, hg_onorm,
              gm_w_in, gm_ln_g, gm_ln_b, gm_ws, gm_bs, ffn_norm, w_ffn_in, w_ffn_out,
              final_norm):
    lb_all = jnp.cumsum(jax.nn.softmax(hg_lb.astype(jnp.float32), axis=0), axis=0)
    for i in range(DEPTH):
        h = rmsnorm(x, mix_norm[i])
        j = i // N_MIXERS
        if i % N_MIXERS == 0:
            p = h @ hg_w_in[j]
            tok = hgrn2_mix(p[..., :4 * D_TOK], lb_all[i]) * hg_onorm[j].astype(jnp.float32)
            qm = p[..., 4 * D_TOK:]
        else:
            p = h @ gm_w_in[j]
            tok = gmlp_mix(p[..., :2 * D_TOK], gm_ln_g[j], gm_ln_b[j], gm_ws[j], gm_bs[j])
            qm = p[..., 2 * D_TOK:]
        mo = mem_attn(qm, mem, mem_norm[i], w_mem_kv[i])
        heads = jnp.concatenate([tok, mo], axis=-1).astype(x.dtype)
        x = x + heads @ w_out[i]
        x = x + swiglu(rmsnorm(x, ffn_norm[i]), w_ffn_in[i], w_ffn_out[i])
    return rmsnorm(x, final_norm)
```

```cpp
#include <hip/hip_runtime.h>
#include <hip/hip_cooperative_groups.h>
#include <cstdio>
#include <cstdint>
namespace cg = cooperative_groups;
#ifndef PROBE
#define PROBE 0
#endif
namespace pg8 {
#define PG8_LAS __attribute__((address_space(3)))
typedef unsigned short bf16_t;
typedef short bf16x8 __attribute__((ext_vector_type(8)));
typedef float f32x4 __attribute__((ext_vector_type(4)));
typedef unsigned u32x4 __attribute__((ext_vector_type(4)));
constexpr int BM = 256, BK = 64, HALF = 128, HTB = HALF * BK * 2  , STAGE_BYTES = 8 * HTB, NXCD = 8, WGM = 8;

__host__ __device__ __forceinline__ int lds_byte(int r, int c) { const int st = (r >> 4) * 2 + (c >> 5), rr = r & 15, cc = c & 31, ob = rr * 64 + cc * 2; return st * 1024 + (ob ^ (((ob >> 9) & 1) << 5)); }
__host__ __device__ __forceinline__ void stage_rc(int b, int& R, int& C) { const int st = b / 1024, sb = b % 1024, swz = sb ^ (((sb >> 9) & 1) << 5); R = (st >> 1) * 16 + swz / 64; C = (st & 1) * 32 + (swz % 64) / 2; }
__host__ __device__ __forceinline__ int perm32(int rho) { const int n = rho >> 4, i = rho & 15; return 8 * (i >> 2) + 4 * n + (i & 3); }

struct Unit { int pm, pn; };
struct Gemm { const bf16_t* A; const bf16_t* Bt; int M, N, K; };

struct StaticOrder {
    int nM, nN, nwg, G, c;
    __host__ __device__ void init(int M, int N, int G_, int c_) { nM = M / BM; nN = N / BM; nwg = nM * nN; G = G_; c = c_; }
    __host__ __device__ bool next(int i, Unit& u) const {
        const long L = (long)i * G + c; if (L >= nwg) return false;
        int wgid = (int)L; { const int q = nwg / NXCD, r = nwg % NXCD, xcd = wgid % NXCD, off = wgid / NXCD; wgid = (xcd < r ? xcd * (q + 1) : r * (q + 1) + (xcd - r) * q) + off; }
        const int nig = WGM * nN, gid = wgid / nig, fm = gid * WGM, gsz = (nM - fm) < WGM ? (nM - fm) : WGM;
        u.pm = fm + ((wgid % nig) % gsz); u.pn = (wgid % nig) / gsz; return true;
    }
    __device__ __forceinline__ void a_ready(const Unit&) const {}
    __device__ __forceinline__ void done(const Unit&) const {}
    __device__ __forceinline__ void after_epi(const Unit&) const {}
};
__device__ __forceinline__ unsigned cvt_pk_bf16(float lo, float hi) { unsigned r; asm volatile("v_cvt_pk_bf16_f32 %0, %1, %2" : "=v"(r) : "v"(lo), "v"(hi)); return r; }
typedef float f32x2 __attribute__((ext_vector_type(2)));
__device__ __forceinline__ f32x2 gelu_pk(f32x2 v) {
    const f32x2 av = __builtin_elementwise_abs(v), d = av * 0.2316418882f + 1.0f;
    f32x2 t; t.x = __builtin_amdgcn_rcpf(d.x); t.y = __builtin_amdgcn_rcpf(d.y);
    f32x2 q = t * 0.5307027145f + (-0.7265760135f); q = q * t + 0.7107068705f; q = q * t + (-0.142248368f); q = q * t + 0.127414796f; q = q * t;
    const f32x2 s = (v * v) * (-0.72134752044f);
    f32x2 e; e.x = __builtin_amdgcn_exp2f(s.x); e.y = __builtin_amdgcn_exp2f(s.y);
    const f32x2 m = v * (q * e), r = v - m;
    f32x2 o; o.x = v.x < 0.f ? m.x : r.x; o.y = v.y < 0.f ? m.y : r.y; return o;
}
template <class Epi, class Sched, bool ALIGN_EPI = false, bool SP2 = false>
__device__ __forceinline__ void gemm_phase(PG8_LAS unsigned char* lds, const Gemm g, const Sched& S, const Epi& E) {
    int tid_ = threadIdx.x; asm volatile("" : "+v"(tid_));
    const int tid = tid_, wid = __builtin_amdgcn_readfirstlane(tid >> 6), lane = tid & 63, wr = wid >> 2, wc = wid & 3, fr = lane & 15, fq = lane >> 4;
    const int K = g.K, nt = K / BK;
    unsigned voffA[2], voffB[2];
#pragma unroll
    for (int i = 0; i < 2; ++i) { int R, C; stage_rc(tid * 16 + i * 8192, R, C); const int Rb = Epi::PERM ? ((R & ~31) + perm32(R & 31)) : R;
        voffA[i] = (unsigned)(R * K + C) * 2u; voffB[i] = (unsigned)(Rb * K + C) * 2u; }
    const size_t kstep = (size_t)(BK * 2);
    const size_t hstep = (size_t)HALF * K * 2;
    const size_t tstep = 2 * hstep;
    const unsigned ldsw = (unsigned)wid * 1024u;
    const int aoff = lds_byte(wr * 64 + fr, fq * 8), boff = lds_byte(wc * 32 + fr, fq * 8);
#define PG8_SA(b, h) (((b) * 2 + (h)) * HTB)
#define PG8_SB(b, h) ((4 + (b) * 2 + (h)) * HTB)
#define PG8_STAGE(bufoff, gbase, voff) do { _Pragma("unroll") for (int _i = 0; _i < 2; ++_i) \
        __builtin_amdgcn_global_load_lds((const unsigned*)((const char*)(gbase) + (voff)[_i]), (PG8_LAS unsigned*)(lds + (bufoff) + ldsw + _i * 8192), 16, 0, 0); } while (0)
#define PG8_LDA(dst, b, h) do { _Pragma("unroll") for (int m = 0; m < 4; ++m) _Pragma("unroll") for (int k = 0; k < 2; ++k) dst[m][k] = *(const PG8_LAS bf16x8*)(lds + PG8_SA(b, h) + aoff + m * 2048 + k * 1024); } while (0)
#define PG8_LDB(dst, b, h) do { _Pragma("unroll") for (int n = 0; n < 2; ++n) _Pragma("unroll") for (int k = 0; k < 2; ++k) dst[n][k] = *(const PG8_LAS bf16x8*)(lds + PG8_SB(b, h) + boff + n * 2048 + k * 1024); } while (0)
#define PG8_MMA(ai, bj, At, Bt) do { __builtin_amdgcn_s_setprio(1); _Pragma("unroll") for (int m = 0; m < 4; ++m) _Pragma("unroll") for (int n = 0; n < 2; ++n) _Pragma("unroll") for (int k = 0; k < 2; ++k) \
        acc[ai][bj][m][n] = __builtin_amdgcn_mfma_f32_16x16x32_bf16(Bt[n][k], At[m][k], acc[ai][bj][m][n], 0, 0, 0); __builtin_amdgcn_s_setprio(0); } while (0)
#define PG8_WAIT_V(n) asm volatile("s_waitcnt vmcnt(" #n ")" ::: "memory")
#define PG8_WAIT_L(n) asm volatile("s_waitcnt lgkmcnt(" #n ")" ::: "memory")
#define PG8_BAR __builtin_amdgcn_s_barrier()
#define PG8_SCHED __builtin_amdgcn_sched_barrier(0)
    Unit cur, nxt; int ui = 0;
    if (!S.next(0, cur)) return;
    f32x4 acc[2][2][4][2];
#pragma unroll
    for (int a = 0; a < 2; ++a)
#pragma unroll
        for (int b = 0; b < 2; ++b)
#pragma unroll
            for (int m = 0; m < 4; ++m)
#pragma unroll
                for (int n = 0; n < 2; ++n) acc[a][b][m][n] = (f32x4){0.f, 0.f, 0.f, 0.f};
    bf16x8 At[4][2], B0[2][2], B1[2][2];
    const char* cA = (const char*)g.A + (size_t)cur.pm * tstep; const char* cB = (const char*)g.Bt + (size_t)cur.pn * tstep;
    S.a_ready(cur); S.after_epi(cur);
    if constexpr (SP2) {
        PG8_STAGE(PG8_SB(0, 0), cB, voffB); PG8_STAGE(PG8_SB(0, 1), cB + hstep, voffB); PG8_STAGE(PG8_SA(0, 0), cA, voffA); PG8_STAGE(PG8_SA(0, 1), cA + hstep, voffA);
        if (wr == 1) PG8_BAR;
        PG8_WAIT_V(2); PG8_BAR;
        PG8_STAGE(PG8_SB(1, 0), cB + kstep, voffB); PG8_STAGE(PG8_SA(1, 0), cA + kstep, voffA); PG8_STAGE(PG8_SB(1, 1), cB + hstep + kstep, voffB);
        PG8_WAIT_V(6); PG8_BAR;
    } else {
        PG8_STAGE(PG8_SB(0, 0), cB, voffB); PG8_STAGE(PG8_SA(0, 0), cA, voffA); PG8_STAGE(PG8_SB(0, 1), cB + hstep, voffB); PG8_STAGE(PG8_SA(0, 1), cA + hstep, voffA);
        if (wr == 1) PG8_BAR;
        PG8_WAIT_V(4); PG8_BAR;
        PG8_STAGE(PG8_SB(1, 0), cB + kstep, voffB); PG8_STAGE(PG8_SA(1, 0), cA + kstep, voffA); PG8_STAGE(PG8_SB(1, 1), cB + hstep + kstep, voffB);
        PG8_WAIT_V(6); PG8_BAR;
    }
    for (;;) {
        const bool has_next = S.next(ui + 1, nxt);
        const char* nA = has_next ? (const char*)g.A + (size_t)nxt.pm * tstep : cA; const char* nB = has_next ? (const char*)g.Bt + (size_t)nxt.pn * tstep : cB;
        for (int t = 0; t < nt; t += 2) {
            const bool last = (t == nt - 2);
            const char* a1 = cA + (size_t)(t + 1) * kstep;
            const char* a2 = last ? nA : cA + (size_t)(t + 2) * kstep; const char* b2 = last ? nB : cB + (size_t)(t + 2) * kstep;
            const char* a3 = a2 + kstep; const char* b3 = b2 + kstep;
            if (last && has_next) S.a_ready(nxt);
            if constexpr (SP2) {
            PG8_LDB(B0, 0, 0); PG8_LDB(B1, 0, 1); PG8_SCHED; PG8_LDA(At, 0, 0); PG8_STAGE(PG8_SA(1, 1), a1 + hstep, voffA);
            PG8_WAIT_V(8); PG8_WAIT_L(0); PG8_BAR; PG8_MMA(0, 0, At, B0); PG8_MMA(0, 1, At, B1); PG8_BAR; PG8_SCHED;
            PG8_LDA(At, 0, 1); PG8_STAGE(PG8_SB(0, 0), b2, voffB); PG8_STAGE(PG8_SB(0, 1), b2 + hstep, voffB); PG8_STAGE(PG8_SA(0, 0), a2, voffA);
            PG8_WAIT_V(8); PG8_WAIT_L(0); PG8_BAR; PG8_MMA(1, 0, At, B0); PG8_MMA(1, 1, At, B1); PG8_BAR; PG8_SCHED;
            PG8_LDB(B0, 1, 0); PG8_LDB(B1, 1, 1); PG8_SCHED; PG8_LDA(At, 1, 0); PG8_STAGE(PG8_SA(0, 1), a2 + hstep, voffA);
            PG8_WAIT_V(8); PG8_WAIT_L(0); PG8_BAR; PG8_MMA(0, 0, At, B0); PG8_MMA(0, 1, At, B1); PG8_BAR; PG8_SCHED;
            PG8_LDA(At, 1, 1); PG8_STAGE(PG8_SB(1, 0), b3, voffB); PG8_STAGE(PG8_SB(1, 1), b3 + hstep, voffB); PG8_STAGE(PG8_SA(1, 0), a3, voffA);
            PG8_WAIT_V(8); PG8_WAIT_L(0); PG8_BAR; PG8_MMA(1, 0, At, B0); PG8_MMA(1, 1, At, B1); PG8_BAR; PG8_SCHED;
            } else {
            PG8_LDB(B0, 0, 0); PG8_SCHED; PG8_LDA(At, 0, 0); PG8_STAGE(PG8_SA(1, 1), a1 + hstep, voffA);
            PG8_WAIT_L(8); PG8_BAR; PG8_WAIT_L(0); PG8_MMA(0, 0, At, B0); PG8_BAR; PG8_SCHED;
            PG8_LDB(B1, 0, 1); PG8_STAGE(PG8_SB(0, 0), b2, voffB);
            PG8_BAR; PG8_WAIT_L(0); PG8_MMA(0, 1, At, B1); PG8_BAR;
            PG8_LDA(At, 0, 1); PG8_STAGE(PG8_SA(0, 0), a2, voffA);
            PG8_BAR; PG8_WAIT_L(0); PG8_MMA(1, 0, At, B0); PG8_BAR; PG8_SCHED;
            PG8_STAGE(PG8_SB(0, 1), b2 + hstep, voffB);
            PG8_WAIT_V(6); PG8_BAR; PG8_MMA(1, 1, At, B1); PG8_BAR;
            PG8_LDB(B0, 1, 0); PG8_SCHED; PG8_LDA(At, 1, 0); PG8_STAGE(PG8_SA(0, 1), a2 + hstep, voffA);
            PG8_WAIT_L(8); PG8_BAR; PG8_WAIT_L(0); PG8_MMA(0, 0, At, B0); PG8_BAR; PG8_SCHED;
            PG8_LDB(B1, 1, 1); PG8_STAGE(PG8_SB(1, 0), b3, voffB);
            PG8_BAR; PG8_WAIT_L(0); PG8_MMA(0, 1, At, B1); PG8_BAR;
            PG8_LDA(At, 1, 1); PG8_STAGE(PG8_SA(1, 0), a3, voffA);
            PG8_BAR; PG8_WAIT_L(0); PG8_MMA(1, 0, At, B0); PG8_BAR; PG8_SCHED;
            PG8_STAGE(PG8_SB(1, 1), b3 + hstep, voffB);
            PG8_WAIT_V(6); PG8_BAR; PG8_MMA(1, 1, At, B1); PG8_BAR;
            }
        }
        if constexpr (ALIGN_EPI) { if (wr == 0) PG8_BAR; }
        if constexpr (!Epi::AFTER_DRAIN) { E(acc, cur, wr, wc, fr, fq); S.done(cur); if (has_next) S.after_epi(nxt); }
        if (!has_next) break;
#pragma unroll
        for (int a = 0; a < 2; ++a)
#pragma unroll
            for (int b = 0; b < 2; ++b)
#pragma unroll
                for (int m = 0; m < 4; ++m)
#pragma unroll
                    for (int n = 0; n < 2; ++n) acc[a][b][m][n] = (f32x4){0.f, 0.f, 0.f, 0.f};
        cur = nxt; cA = nA; cB = nB; ++ui;
        if constexpr (ALIGN_EPI) { if (wr == 1) PG8_BAR; }
    }
    PG8_WAIT_V(0);
    if constexpr (!ALIGN_EPI) { if (wr == 0) PG8_BAR; }
    PG8_BAR;
    if constexpr (Epi::AFTER_DRAIN) { E.fused(acc, cur, wr, wc, fr, fq, lds, wid, lane); S.done(cur); }
#undef PG8_SA
#undef PG8_SB
#undef PG8_STAGE
#undef PG8_LDA
#undef PG8_LDB
#undef PG8_MMA
#undef PG8_WAIT_V
#undef PG8_WAIT_L
#undef PG8_BAR
#undef PG8_SCHED
}
}

#define LAS __attribute__((address_space(3)))
#define GAS __attribute__((address_space(1)))
typedef unsigned short bf16;
typedef float f32x4 __attribute__((ext_vector_type(4)));
typedef float f32x2 __attribute__((ext_vector_type(2)));
typedef short bf16x8 __attribute__((ext_vector_type(8)));
typedef unsigned u32x4 __attribute__((ext_vector_type(4)));
typedef unsigned u32x2 __attribute__((ext_vector_type(2)));
using pg8::cvt_pk_bf16;
using pg8::Unit;

constexpr int NB_ = 8, SEQ = 4096, D = 1024, M = NB_ * SEQ;
constexpr int DT = 768, DM = 256, NA = 4 * DT + DM, NBW = 2 * DT + DM, FF = 2816, NF = 2 * FF, ML = 256, MM = NB_ * ML;
constexpr float EPS = 1e-6f;
constexpr float QSCALE = 0.125f * 1.44269504089f;
constexpr int LDS_BYTES = 147456;

constexpr size_t MiB = 1u << 20;
constexpr size_t WS_WINA = 0, WS_WINB = 7 * MiB, WS_WOUT = 11 * MiB, WS_WFFI = 15 * MiB, WS_WFFO = 37 * MiB, WS_WKV = 48 * MiB, WS_WSB = 50 * MiB,
                 WS_MISC = 51 * MiB, WS_PART = 52 * MiB, WS_LNP = 54 * MiB, WS_MPART = 57 * MiB, WS_MEMB = 58 * MiB, WS_KV = 62 * MiB, WS_XB = 66 * MiB,
                 WS_HEADS = 130 * MiB, WS_QM = 194 * MiB, WS_R = 210 * MiB, WS_Q = WS_R, WS_V = WS_R + 48 * MiB, WS_G = WS_R + 96 * MiB, WS_LF = WS_R + 144 * MiB,
                 WS_ACT = WS_R, WS_END = 450 * MiB, WS_BAR = WS_MISC + 65536;

__device__ __forceinline__ float bf2f(unsigned short b) { return __uint_as_float(((unsigned)b) << 16); }
__device__ __forceinline__ float bflo(unsigned w) { return __uint_as_float(w << 16); }
__device__ __forceinline__ float bfhi(unsigned w) { return __uint_as_float(w & 0xffff0000u); }
__device__ __forceinline__ unsigned short f2bf(float f) { return (unsigned short)(cvt_pk_bf16(f, 0.f) & 0xffffu); }
__device__ __forceinline__ float wave_sum(float v) {
#pragma unroll
    for (int o = 1; o < 64; o <<= 1) v += __shfl_xor(v, o);
    return v;
}
__device__ __forceinline__ float sum16(const float* p) {
    const f32x4 a = ((const f32x4*)p)[0], b = ((const f32x4*)p)[1], c = ((const f32x4*)p)[2], d = ((const f32x4*)p)[3];
    return (((a.x + a.y) + (a.z + a.w)) + ((b.x + b.y) + (b.z + b.w))) + (((c.x + c.y) + (c.z + c.w)) + ((d.x + d.y) + (d.z + d.w)));
}
__device__ __forceinline__ float row_rstd(const float* ss, int row) { return rsqrtf(ss[row] * (1.0f / 1024.0f) + EPS); }
__device__ __forceinline__ float lds_rstd(const LAS float* rs, int r) { return __builtin_amdgcn_rsqf(rs[r] * (1.0f / 1024.0f) + EPS); }
__device__ __forceinline__ f32x4 sigmoid4(f32x4 x) { const f32x4 t = x * -1.44269504089f; f32x4 e; e[0] = __builtin_amdgcn_exp2f(t[0]); e[1] = __builtin_amdgcn_exp2f(t[1]); e[2] = __builtin_amdgcn_exp2f(t[2]); e[3] = __builtin_amdgcn_exp2f(t[3]);
    e = e + 1.0f; f32x4 r; r[0] = __builtin_amdgcn_rcpf(e[0]); r[1] = __builtin_amdgcn_rcpf(e[1]); r[2] = __builtin_amdgcn_rcpf(e[2]); r[3] = __builtin_amdgcn_rcpf(e[3]); return r; }
__device__ __forceinline__ float sigmoidf_(float x) { return __builtin_amdgcn_rcpf(1.0f + __builtin_amdgcn_exp2f(x * -1.44269504089f)); }

struct RsOrder : pg8::StaticOrder { const GAS float* ss; mutable float pa, pb; mutable int nth;
    __device__ __forceinline__ void after_epi(const Unit& u) const { if (nth > 0) { const int t = threadIdx.x, r = u.pm * 256 + ((t >> 8) & 1) * 64 + (t & 63); pa = ss[r]; pb = ss[r + 128]; } ++nth; } };
__device__ __forceinline__ float shfl_rstd(const RsOrder* sc, bool first, int row, int ai, int m, int fr) {
    float s; if (first) s = sc->ss[row]; else s = __shfl(ai ? sc->pb : sc->pa, m * 16 + fr);
    return __builtin_amdgcn_rsqf(s * (1.0f / 1024.0f) + EPS); }
struct EpiProjA {
    static constexpr bool PERM = true, AFTER_DRAIN = false;
    const RsOrder* sc; LAS float* rs; GAS bf16* Q; GAS float* LF; GAS bf16* V; GAS bf16* G; GAS bf16* QM; const GAS float* lb; const GAS float* onorm;
    __device__ __forceinline__ void operator()(const f32x4 (&acc)[2][2][4][2], const Unit& u, int wr, int wc, int fr, int fq) const {
        const bool first = true;
        const int row0 = u.pm * 256 + wr * 64 + fr;
        const int type = u.pn / 3, col0 = (u.pn - type * 3) * 256 + wc * 32 + 8 * fq;
        f32x4 aux[2][2];
#pragma unroll
        for (int bj = 0; bj < 2; ++bj)
#pragma unroll
            for (int n = 0; n < 2; ++n) { aux[bj][n] = (f32x4){0.f, 0.f, 0.f, 0.f};
                if (type == 1) aux[bj][n] = *(const GAS f32x4*)(lb + col0 + bj * 128 + 4 * n);
                if (type == 3) aux[bj][n] = *(const GAS f32x4*)(onorm + col0 + bj * 128 + 4 * n); }
#pragma unroll
        for (int ai = 0; ai < 2; ++ai)
#pragma unroll
            for (int m = 0; m < 4; ++m) {
                const int row = row0 + ai * 128 + m * 16; const float rs = shfl_rstd(sc, first, row, ai, m, fr);
#pragma unroll
                for (int bj = 0; bj < 2; ++bj) {
                    f32x4 v0 = acc[ai][bj][m][0] * rs, v1 = acc[ai][bj][m][1] * rs; const int col = col0 + bj * 128;
                    if (type == 1) {
                        const f32x4 s0 = sigmoid4(v0), s1 = sigmoid4(v1), l0 = aux[bj][0], l1 = aux[bj][1];
                        const f32x4 f0 = l0 + (1.0f - l0) * s0, f1 = l1 + (1.0f - l1) * s1; f32x4 o0, o1;
#pragma unroll
                        for (int j = 0; j < 4; ++j) { o0[j] = __builtin_amdgcn_logf(f0[j]); o1[j] = __builtin_amdgcn_logf(f1[j]); }
                        o0 = o0 * 0.69314718056f; o1 = o1 * 0.69314718056f;
                        GAS float* p = LF + (size_t)row * DT + col; *(GAS f32x4*)p = o0; *(GAS f32x4*)(p + 4) = o1;
                    } else {
                        GAS bf16* dst;
                        if (type == 0) dst = Q + (size_t)row * DT + col;
                        else if (type == 2) dst = V + (size_t)row * DT + col;
                        else if (type == 3) { dst = G + (size_t)row * DT + col;
                            v0 = v0 * sigmoid4(v0) * aux[bj][0]; v1 = v1 * sigmoid4(v1) * aux[bj][1]; }
                        else { dst = QM + (size_t)row * DM + col; v0 = v0 * QSCALE; v1 = v1 * QSCALE; }
                        u32x4 w; w.x = cvt_pk_bf16(v0[0], v0[1]); w.y = cvt_pk_bf16(v0[2], v0[3]); w.z = cvt_pk_bf16(v1[0], v1[1]); w.w = cvt_pk_bf16(v1[2], v1[3]);
                        *(GAS u32x4*)dst = w;
                    }
                }
            }
    }
};
struct EpiProjB {
    static constexpr bool PERM = true, AFTER_DRAIN = false;
    const RsOrder* sc; LAS float* rs; GAS bf16* U; GAS bf16* VG; GAS bf16* QM; GAS float* lnp;
    __device__ __forceinline__ void operator()(const f32x4 (&acc)[2][2][4][2], const Unit& u, int wr, int wc, int fr, int fq) const {
        const bool first = true;
        const int row0 = u.pm * 256 + wr * 64 + fr;
        const int type = u.pn / 3, col0 = (u.pn - type * 3) * 256 + wc * 32 + 8 * fq;
#pragma unroll
        for (int ai = 0; ai < 2; ++ai)
#pragma unroll
            for (int m = 0; m < 4; ++m) {
                const int row = row0 + ai * 128 + m * 16; const float rs = shfl_rstd(sc, first, row, ai, m, fr);
                float s1[2] = {0.f, 0.f}, s2[2] = {0.f, 0.f};
#pragma unroll
                for (int bj = 0; bj < 2; ++bj) {
                    f32x4 v0 = acc[ai][bj][m][0] * rs, v1 = acc[ai][bj][m][1] * rs; const int col = col0 + bj * 128;
                    GAS bf16* dst;
                    if (type == 2) { dst = QM + (size_t)row * DM + col; v0 = v0 * QSCALE; v1 = v1 * QSCALE; }
                    else {
                        const f32x2 a = pg8::gelu_pk((f32x2){v0[0], v0[1]}), b = pg8::gelu_pk((f32x2){v0[2], v0[3]}), c = pg8::gelu_pk((f32x2){v1[0], v1[1]}), d = pg8::gelu_pk((f32x2){v1[2], v1[3]});
                        v0 = (f32x4){a.x, a.y, b.x, b.y}; v1 = (f32x4){c.x, c.y, d.x, d.y};
                        dst = (type == 0 ? U : VG) + (size_t)row * DT + col;
                        s1[bj] = ((v0[0] + v0[1]) + (v0[2] + v0[3])) + ((v1[0] + v1[1]) + (v1[2] + v1[3]));
                        s2[bj] = ((v0[0] * v0[0] + v0[1] * v0[1]) + (v0[2] * v0[2] + v0[3] * v0[3])) + ((v1[0] * v1[0] + v1[1] * v1[1]) + (v1[2] * v1[2] + v1[3] * v1[3]));
                    }
                    u32x4 w; w.x = cvt_pk_bf16(v0[0], v0[1]); w.y = cvt_pk_bf16(v0[2], v0[3]); w.z = cvt_pk_bf16(v1[0], v1[1]); w.w = cvt_pk_bf16(v1[2], v1[3]);
                    *(GAS u32x4*)dst = w;
                }
                if (type == 1) {
                    float a = s1[0] + s1[1], b = s2[0] + s2[1]; a += __shfl_xor(a, 16); a += __shfl_xor(a, 32); b += __shfl_xor(b, 16); b += __shfl_xor(b, 32);
                    if (fq == 0) { GAS float* p = lnp + (size_t)row * 24 + ((u.pn - 3) * 4 + wc) * 2; *(GAS f32x2*)p = (f32x2){a, b}; }
                }
            }
    }
};
struct EpiKV {
    static constexpr bool PERM = true, AFTER_DRAIN = false;
    const RsOrder* sc; LAS float* rs; GAS bf16* O;
    __device__ __forceinline__ void operator()(const f32x4 (&acc)[2][2][4][2], const Unit& u, int wr, int wc, int fr, int fq) const {
        const bool first = true;
        const int row0 = u.pm * 256 + wr * 64 + fr, col0 = u.pn * 256 + wc * 32 + 8 * fq;
#pragma unroll
        for (int ai = 0; ai < 2; ++ai)
#pragma unroll
            for (int m = 0; m < 4; ++m) {
                const int row = row0 + ai * 128 + m * 16; const float rs = shfl_rstd(sc, first, row, ai, m, fr);
#pragma unroll
                for (int bj = 0; bj < 2; ++bj) { const f32x4 v0 = acc[ai][bj][m][0] * rs, v1 = acc[ai][bj][m][1] * rs;
                    u32x4 w; w.x = cvt_pk_bf16(v0[0], v0[1]); w.y = cvt_pk_bf16(v0[2], v0[3]); w.z = cvt_pk_bf16(v1[0], v1[1]); w.w = cvt_pk_bf16(v1[2], v1[3]);
                    *(GAS u32x4*)(O + (size_t)row * 1024 + col0 + bj * 128) = w; }
            }
    }
};
struct EpiRes {
    static constexpr bool PERM = true, AFTER_DRAIN = false;
    const GAS float* base32; GAS float* out32; GAS bf16* xb; GAS float* part;
    __device__ __forceinline__ void operator()(const f32x4 (&acc)[2][2][4][2], const Unit& u, int wr, int wc, int fr, int fq) const {
        const int row0 = u.pm * 256 + wr * 64 + fr, col0 = u.pn * 256 + wc * 32 + 8 * fq;
#pragma unroll
        for (int ai = 0; ai < 2; ++ai)
#pragma unroll
            for (int m = 0; m < 4; ++m) {
                const int row = row0 + ai * 128 + m * 16; f32x4 sv = (f32x4){0.f, 0.f, 0.f, 0.f};
#pragma unroll
                for (int bj = 0; bj < 2; ++bj) { const size_t off = (size_t)row * D + col0 + bj * 128;
                    f32x4 x0, x1;
                    if (base32) { x0 = __builtin_nontemporal_load((const GAS f32x4*)(base32 + off)); x1 = __builtin_nontemporal_load((const GAS f32x4*)(base32 + off + 4)); }
                    else { const u32x4 w = *(const GAS u32x4*)(xb + off); x0 = (f32x4){bflo(w.x), bfhi(w.x), bflo(w.y), bfhi(w.y)}; x1 = (f32x4){bflo(w.z), bfhi(w.z), bflo(w.w), bfhi(w.w)}; }
                    x0 = x0 + acc[ai][bj][m][0]; x1 = x1 + acc[ai][bj][m][1];
                    if (out32) { *(GAS f32x4*)(out32 + off) = x0; *(GAS f32x4*)(out32 + off + 4) = x1; }
                    else { u32x4 w; w.x = cvt_pk_bf16(x0[0], x0[1]); w.y = cvt_pk_bf16(x0[2], x0[3]); w.z = cvt_pk_bf16(x1[0], x1[1]); w.w = cvt_pk_bf16(x1[2], x1[3]); *(GAS u32x4*)(xb + off) = w; }
                    sv = sv + x0 * x0; sv = sv + x1 * x1; }
                float ss = (sv[0] + sv[1]) + (sv[2] + sv[3]);
                ss += __shfl_xor(ss, 16); ss += __shfl_xor(ss, 32);
                if (fq == 0) __hip_atomic_fetch_add((GAS float*)(part + row), ss, __ATOMIC_RELAXED, __HIP_MEMORY_SCOPE_AGENT);
            }
    }
};
struct EpiFfn {
    static constexpr bool PERM = true, AFTER_DRAIN = false;
    const RsOrder* sc; LAS float* rs; GAS bf16* ACT;
    __device__ __forceinline__ void operator()(const f32x4 (&acc)[2][2][4][2], const Unit& u, int wr, int wc, int fr, int fq) const {
        const bool first = true;
        const int row0 = u.pm * 256 + wr * 64 + fr, col0 = u.pn * 128 + wc * 32 + 8 * fq;
#pragma unroll
        for (int ai = 0; ai < 2; ++ai)
#pragma unroll
            for (int m = 0; m < 4; ++m) {
                const int row = row0 + ai * 128 + m * 16; const float rs = shfl_rstd(sc, first, row, ai, m, fr), rs2 = rs * -1.44269504089f, rsq = rs * rs;
                f32x4 o[2];
#pragma unroll
                for (int n = 0; n < 2; ++n) {
                    const f32x4 g = acc[ai][0][m][n], up = acc[ai][1][m][n]; const f32x4 t = g * rs2; f32x4 e;
                    e[0] = __builtin_amdgcn_exp2f(t[0]); e[1] = __builtin_amdgcn_exp2f(t[1]); e[2] = __builtin_amdgcn_exp2f(t[2]); e[3] = __builtin_amdgcn_exp2f(t[3]);
                    e = e + 1.0f; f32x4 r; r[0] = __builtin_amdgcn_rcpf(e[0]); r[1] = __builtin_amdgcn_rcpf(e[1]); r[2] = __builtin_amdgcn_rcpf(e[2]); r[3] = __builtin_amdgcn_rcpf(e[3]);
                    o[n] = (g * up) * (r * rsq); }
                u32x4 w; w.x = cvt_pk_bf16(o[0][0], o[0][1]); w.y = cvt_pk_bf16(o[0][2], o[0][3]); w.z = cvt_pk_bf16(o[1][0], o[1][1]); w.w = cvt_pk_bf16(o[1][2], o[1][3]);
                *(GAS u32x4*)(ACT + (size_t)row * FF + col0) = w;
            }
    }
};

__device__ __forceinline__ void transpose_item(const float* W, int K, int N, const float* gain, bf16* WT, int k0, int n0, int orow0, LAS float* scr, int lane) {
    float tv[32];
#pragma unroll
    for (int i = 0; i < 32; ++i) tv[i] = __builtin_nontemporal_load(W + (size_t)(k0 + 2 * i + (lane >> 5)) * N + n0 + (lane & 31));
    if (gain) {
#pragma unroll
        for (int i = 0; i < 32; ++i) tv[i] *= gain[k0 + 2 * i + (lane >> 5)]; }
#pragma unroll
    for (int i = 0; i < 32; ++i) scr[(2 * i + (lane >> 5)) * 33 + (lane & 31)] = tv[i];
    asm volatile("s_waitcnt lgkmcnt(0)" ::: "memory");
    const int c = lane & 7;
#pragma unroll
    for (int j = 0; j < 4; ++j) { const int n = (lane >> 3) + 8 * j; const LAS float* s = scr + (8 * c) * 33 + n;
        u32x4 o; o.x = cvt_pk_bf16(s[0 * 33], s[1 * 33]); o.y = cvt_pk_bf16(s[2 * 33], s[3 * 33]); o.z = cvt_pk_bf16(s[4 * 33], s[5 * 33]); o.w = cvt_pk_bf16(s[6 * 33], s[7 * 33]);
        *(u32x4*)(WT + (size_t)(orow0 + n) * K + k0 + 8 * c) = o; }
    asm volatile("s_waitcnt lgkmcnt(0)" ::: "memory");
}
template <int NR> __device__ __forceinline__ void rows_to_bf16(const float* xrow, bf16* orow, float* part, int lane) {
    f32x4 v[NR][4];
#pragma unroll
    for (int r = 0; r < NR; ++r)
#pragma unroll
        for (int j = 0; j < 4; ++j) v[r][j] = __builtin_nontemporal_load((const f32x4*)(xrow + (size_t)r * D) + lane + 64 * j);
#pragma unroll
    for (int r = 0; r < NR; ++r) { float s = 0.f;
#pragma unroll
        for (int j = 0; j < 4; ++j) s += (v[r][j].x * v[r][j].x + v[r][j].y * v[r][j].y) + (v[r][j].z * v[r][j].z + v[r][j].w * v[r][j].w);
        s = wave_sum(s);
        u32x2* o8 = (u32x2*)(orow + (size_t)r * D) + lane;
#pragma unroll
        for (int j = 0; j < 4; ++j) { u32x2 w; w.x = cvt_pk_bf16(v[r][j].x, v[r][j].y); w.y = cvt_pk_bf16(v[r][j].z, v[r][j].w); o8[64 * j] = w; }
        if (lane == 0) part[r] = s; }
}

__device__ __forceinline__ void convert_matrix(const float* W, int K, int N, const float* gain, bf16* WT, bool ffn_perm, int rowoff, int gw, int NGW, LAS float* scr, int lane) {
    const int nb = N / 32, nit = (K / 64) * nb;
    for (int r = gw; r < nit; r += NGW) { const int k0 = (r / nb) * 64, n0 = (r % nb) * 32; int orow0 = rowoff + n0;
        if (ffn_perm) { const int up = n0 >= FF ? 1 : 0, nn = n0 - up * FF; orow0 = 256 * (nn / 128) + 128 * up + (nn % 128); }
        transpose_item(W, K, N, gain, WT, k0, n0, orow0, scr, lane); }
}
struct Args { const float* in[18]; float* out; unsigned char* ws; };
__device__ __forceinline__ void convert_group(const Args& a, unsigned char* ws, int grp, int gw, int NGW, LAS float* scr, int lane) {
    if (grp == 1) convert_matrix(a.in[9], D, NBW, a.in[2] + D, (bf16*)(ws + WS_WINB), false, 0, gw, NGW, scr, lane);
    const int l = grp - 1;
    convert_matrix(a.in[5] + (size_t)l * D * D, D, D, nullptr, (bf16*)(ws + WS_WOUT) + (size_t)l * D * D, false, 0, gw, NGW, scr, lane);
    convert_matrix(a.in[15] + (size_t)l * D * NF, D, NF, a.in[14] + l * D, (bf16*)(ws + WS_WFFI) + (size_t)l * NF * D, true, 0, gw, NGW, scr, lane);
    convert_matrix(a.in[16] + (size_t)l * FF * D, FF, D, nullptr, (bf16*)(ws + WS_WFFO) + (size_t)l * D * FF, false, 0, gw, NGW, scr, lane);
}
struct ReverseOrder : pg8::StaticOrder { int R; __device__ void initr(int M_, int N_, int G_, int c_) { init(M_, N_, G_, c_); R = (nwg + G_ - 1) / G_; }
    __device__ bool next(int i, Unit& u) const { return i < R && pg8::StaticOrder::next(R - 1 - i, u); } };

__device__ __forceinline__ void memattn_unit(LAS unsigned char* lds, const bf16* QM, const bf16* KV, bf16* HEADS, int layer, int tile, int h, int tid) {
    LAS bf16* Ks = (LAS bf16*)lds;
    LAS bf16* Vt = (LAS bf16*)(lds + 36864);
    const int lane = tid & 63, wave = tid >> 6, fr = lane & 15, fq = lane >> 4;
    const int b = tile >> 4;
    { const int key = tid >> 1, half = tid & 1;
      const bf16* kp = KV + (size_t)(b * ML + key) * 1024 + layer * 512 + h * 64 + half * 32; const bf16* vp = kp + 256;
#pragma unroll
      for (int i = 0; i < 4; ++i) *(LAS u32x4*)(Ks + key * 72 + half * 32 + i * 8) = *(const u32x4*)(kp + i * 8);
#pragma unroll
      for (int i = 0; i < 4; ++i) { const u32x4 w = *(const u32x4*)(vp + i * 8); const unsigned ww[4] = {w.x, w.y, w.z, w.w};
#pragma unroll
          for (int j = 0; j < 4; ++j) { const int d = half * 32 + i * 8 + j * 2; Vt[d * 264 + key] = (bf16)(ww[j] & 0xffffu); Vt[(d + 1) * 264 + key] = (bf16)(ww[j] >> 16); } } }
    __syncthreads();
    for (int qt = 0; qt < 2; ++qt) {
        const int q = tile * 256 + wave * 32 + qt * 16 + fr;
        bf16x8 qf[2];
#pragma unroll
        for (int ks = 0; ks < 2; ++ks) qf[ks] = *(const bf16x8*)(QM + (size_t)q * DM + h * 64 + ks * 32 + 8 * fq);
        f32x4 s[16];
#pragma unroll
        for (int kt = 0; kt < 16; ++kt) { s[kt] = (f32x4){0.f, 0.f, 0.f, 0.f};
#pragma unroll
            for (int ks = 0; ks < 2; ++ks) { const bf16x8 a = *(const LAS bf16x8*)(Ks + (kt * 16 + fr) * 72 + ks * 32 + 8 * fq); s[kt] = __builtin_amdgcn_mfma_f32_16x16x32_bf16(a, qf[ks], s[kt], 0, 0, 0); } }
        float mx = -3.0e38f;
#pragma unroll
        for (int kt = 0; kt < 16; ++kt) mx = fmaxf(fmaxf(fmaxf(s[kt][0], s[kt][1]), fmaxf(s[kt][2], s[kt][3])), mx);
        mx = fmaxf(mx, __shfl_xor(mx, 16)); mx = fmaxf(mx, __shfl_xor(mx, 32));
        float sum = 0.f;
#pragma unroll
        for (int kt = 0; kt < 16; ++kt) {
#pragma unroll
            for (int j = 0; j < 4; ++j) { s[kt][j] = __builtin_amdgcn_exp2f(s[kt][j] - mx); sum += s[kt][j]; } }
        sum += __shfl_xor(sum, 16); sum += __shfl_xor(sum, 32);
        const float inv = 1.0f / sum;
        f32x4 o[4];
#pragma unroll
        for (int dt = 0; dt < 4; ++dt) o[dt] = (f32x4){0.f, 0.f, 0.f, 0.f};
#pragma unroll
        for (int k2 = 0; k2 < 8; ++k2) {
            u32x4 pw; pw.x = cvt_pk_bf16(s[2 * k2][0], s[2 * k2][1]); pw.y = cvt_pk_bf16(s[2 * k2][2], s[2 * k2][3]); pw.z = cvt_pk_bf16(s[2 * k2 + 1][0], s[2 * k2 + 1][1]); pw.w = cvt_pk_bf16(s[2 * k2 + 1][2], s[2 * k2 + 1][3]);
            const bf16x8 pb = __builtin_bit_cast(bf16x8, pw);
#pragma unroll
            for (int dt = 0; dt < 4; ++dt) {
                const u32x2 e0 = *(const LAS u32x2*)(Vt + (dt * 16 + fr) * 264 + (2 * k2) * 16 + 4 * fq), e1 = *(const LAS u32x2*)(Vt + (dt * 16 + fr) * 264 + (2 * k2 + 1) * 16 + 4 * fq);
                u32x4 aw; aw.x = e0.x; aw.y = e0.y; aw.z = e1.x; aw.w = e1.y;
                o[dt] = __builtin_amdgcn_mfma_f32_16x16x32_bf16(__builtin_bit_cast(bf16x8, aw), pb, o[dt], 0, 0, 0); }
        }
#pragma unroll
        for (int dt = 0; dt < 4; ++dt) { u32x2 w; w.x = cvt_pk_bf16(o[dt][0] * inv, o[dt][1] * inv); w.y = cvt_pk_bf16(o[dt][2] * inv, o[dt][3] * inv);
            *(u32x2*)(HEADS + (size_t)q * D + DT + h * 64 + dt * 16 + 4 * fq) = w; }
    }
    __syncthreads();
}
__device__ __forceinline__ void memattn_block(LAS unsigned char* lds, const GAS bf16* QM, const GAS bf16* KV, GAS bf16* HEADS, int layer, int first, int stride, int limit, int tid) {
    LAS bf16* Ks = (LAS bf16*)lds;
    LAS bf16* Vt = (LAS bf16*)(lds + 36864);
    const int lane = tid & 63, wave = tid >> 6, fr = lane & 15, fq = lane >> 4;
    const int key = tid >> 1, half = tid & 1;
    if (first >= limit) return;
    u32x4 kr[4], vr[4];
#define MA_LOAD(u_) do { const int b_ = ((u_) >> 2) >> 4; const GAS bf16* kp_ = KV + (size_t)(b_ * ML + key) * 1024 + layer * 512 + ((u_) & 3) * 64 + half * 32; \
        _Pragma("unroll") for (int i = 0; i < 4; ++i) { kr[i] = *(const GAS u32x4*)(kp_ + i * 8); vr[i] = *(const GAS u32x4*)(kp_ + 256 + i * 8); } } while (0)
    int unit = first;
    MA_LOAD(unit);
    for (;;) {
        const int tile = unit >> 2, h = unit & 3;
#pragma unroll
        for (int i = 0; i < 4; ++i) *(LAS u32x4*)(Ks + key * 72 + half * 32 + i * 8) = kr[i];
#pragma unroll
        for (int i = 0; i < 4; ++i) { const unsigned ww[4] = {vr[i].x, vr[i].y, vr[i].z, vr[i].w};
#pragma unroll
            for (int j = 0; j < 4; ++j) { const int d = half * 32 + i * 8 + j * 2; Vt[d * 264 + key] = (bf16)(ww[j] & 0xffffu); Vt[(d + 1) * 264 + key] = (bf16)(ww[j] >> 16); } }
        __syncthreads();
        bf16x8 qall[2][2];
#pragma unroll
        for (int qt = 0; qt < 2; ++qt)
#pragma unroll
            for (int ks = 0; ks < 2; ++ks) qall[qt][ks] = *(const GAS bf16x8*)(QM + (size_t)(tile * 256 + wave * 32 + qt * 16 + fr) * DM + h * 64 + ks * 32 + 8 * fq);
        const int next = unit + stride; const bool has_next = next < limit;
        if (has_next) MA_LOAD(next);
    for (int qt = 0; qt < 2; ++qt) {
        const int q = tile * 256 + wave * 32 + qt * 16 + fr;
        bf16x8 qf[2];
#pragma unroll
        for (int ks = 0; ks < 2; ++ks) qf[ks] = qall[qt][ks];
        f32x4 s[16];
#pragma unroll
        for (int kt = 0; kt < 16; ++kt) { s[kt] = (f32x4){0.f, 0.f, 0.f, 0.f};
#pragma unroll
            for (int ks = 0; ks < 2; ++ks) { const bf16x8 a = *(const LAS bf16x8*)(Ks + (kt * 16 + fr) * 72 + ks * 32 + 8 * fq); s[kt] = __builtin_amdgcn_mfma_f32_16x16x32_bf16(a, qf[ks], s[kt], 0, 0, 0); } }
        float mx = -3.0e38f;
#pragma unroll
        for (int kt = 0; kt < 16; ++kt) mx = fmaxf(fmaxf(fmaxf(s[kt][0], s[kt][1]), fmaxf(s[kt][2], s[kt][3])), mx);
        mx = fmaxf(mx, __shfl_xor(mx, 16)); mx = fmaxf(mx, __shfl_xor(mx, 32));
        float sum = 0.f;
#pragma unroll
        for (int kt = 0; kt < 16; ++kt) {
#pragma unroll
            for (int j = 0; j < 4; ++j) { s[kt][j] = __builtin_amdgcn_exp2f(s[kt][j] - mx); sum += s[kt][j]; } }
        sum += __shfl_xor(sum, 16); sum += __shfl_xor(sum, 32);
        const float inv = 1.0f / sum;
        f32x4 o[4];
#pragma unroll
        for (int dt = 0; dt < 4; ++dt) o[dt] = (f32x4){0.f, 0.f, 0.f, 0.f};
#pragma unroll
        for (int k2 = 0; k2 < 8; ++k2) {
            u32x4 pw; pw.x = cvt_pk_bf16(s[2 * k2][0], s[2 * k2][1]); pw.y = cvt_pk_bf16(s[2 * k2][2], s[2 * k2][3]); pw.z = cvt_pk_bf16(s[2 * k2 + 1][0], s[2 * k2 + 1][1]); pw.w = cvt_pk_bf16(s[2 * k2 + 1][2], s[2 * k2 + 1][3]);
            const bf16x8 pb = __builtin_bit_cast(bf16x8, pw);
#pragma unroll
            for (int dt = 0; dt < 4; ++dt) {
                const u32x2 e0 = *(const LAS u32x2*)(Vt + (dt * 16 + fr) * 264 + (2 * k2) * 16 + 4 * fq), e1 = *(const LAS u32x2*)(Vt + (dt * 16 + fr) * 264 + (2 * k2 + 1) * 16 + 4 * fq);
                u32x4 aw; aw.x = e0.x; aw.y = e0.y; aw.z = e1.x; aw.w = e1.y;
                o[dt] = __builtin_amdgcn_mfma_f32_16x16x32_bf16(__builtin_bit_cast(bf16x8, aw), pb, o[dt], 0, 0, 0); }
        }
#pragma unroll
        for (int dt = 0; dt < 4; ++dt) { u32x2 w; w.x = cvt_pk_bf16(o[dt][0] * inv, o[dt][1] * inv); w.y = cvt_pk_bf16(o[dt][2] * inv, o[dt][3] * inv);
            *(GAS u32x2*)(HEADS + (size_t)q * D + DT + h * 64 + dt * 16 + 4 * fq) = w; }
    }
        __syncthreads();
        if (!has_next) break;
        unit = next;
    }
#undef MA_LOAD
}

__device__ __forceinline__ void gmlp_unit(LAS unsigned char* lds, const bf16* U, const bf16* VG, const float* lnp, const float* ln_g, const float* ln_b, const bf16* WSB, const float* bsv,
                                          bf16* HEADS, int unit, int tid) {
    LAS bf16* VnT = (LAS bf16*)lds;
    const int lane = tid & 63, wave = tid >> 6, fr = lane & 15, fq = lane >> 4;
    const int g = unit % 6, bn = unit / 6; const int row0 = bn * 128;
    { const int s = tid & 127, cq = tid >> 7; const int row = row0 + s;
      float s1 = 0.f, s2 = 0.f; const f32x4* lp = (const f32x4*)(lnp + (size_t)row * 24);
#pragma unroll
      for (int i = 0; i < 6; ++i) { const f32x4 t = lp[i]; s1 += t.x + t.z; s2 += t.y + t.w; }
      const float mu = s1 * (1.0f / 768.0f), var = s2 * (1.0f / 768.0f) - mu * mu, rstd = rsqrtf(var + EPS);
      const bf16* vp = VG + (size_t)row * DT + g * 128 + cq * 32;
#pragma unroll
      for (int i = 0; i < 4; ++i) { const u32x4 w = *(const u32x4*)(vp + i * 8); const unsigned ww[4] = {w.x, w.y, w.z, w.w};
          const f32x4 g0 = *(const f32x4*)(ln_g + g * 128 + cq * 32 + i * 8), g1 = *(const f32x4*)(ln_g + g * 128 + cq * 32 + i * 8 + 4);
          const f32x4 b0 = *(const f32x4*)(ln_b + g * 128 + cq * 32 + i * 8), b1 = *(const f32x4*)(ln_b + g * 128 + cq * 32 + i * 8 + 4);
          const float gg[8] = {g0.x, g0.y, g0.z, g0.w, g1.x, g1.y, g1.z, g1.w}, bb[8] = {b0.x, b0.y, b0.z, b0.w, b1.x, b1.y, b1.z, b1.w};
#pragma unroll
          for (int j = 0; j < 4; ++j) { const int c = cq * 32 + i * 8 + j * 2;
              const float x0 = (bflo(ww[j]) - mu) * rstd * gg[2 * j] + bb[2 * j], x1 = (bfhi(ww[j]) - mu) * rstd * gg[2 * j + 1] + bb[2 * j + 1];
              const unsigned pk = cvt_pk_bf16(x0, x1); VnT[c * 136 + s] = (bf16)(pk & 0xffffu); VnT[(c + 1) * 136 + s] = (bf16)(pk >> 16); } } }
    __syncthreads();
    {
        const int t = wave * 16 + fr;
        bf16x8 wf[4];
#pragma unroll
        for (int ks = 0; ks < 4; ++ks) wf[ks] = *(const bf16x8*)(WSB + (size_t)g * 16384 + t * 128 + ks * 32 + 8 * fq);
        const float bias = bsv[g * 128 + t];
        const int row = row0 + t;
#pragma unroll
        for (int ct = 0; ct < 8; ++ct) {
            f32x4 acc = (f32x4){0.f, 0.f, 0.f, 0.f};
#pragma unroll
            for (int ks = 0; ks < 4; ++ks) { const bf16x8 a = *(const LAS bf16x8*)(VnT + (ct * 16 + fr) * 136 + ks * 32 + 8 * fq); acc = __builtin_amdgcn_mfma_f32_16x16x32_bf16(a, wf[ks], acc, 0, 0, 0); }
            const int col = g * 128 + ct * 16 + 4 * fq;
            const u32x2 uw = *(const u32x2*)(U + (size_t)row * DT + col);
            u32x2 w; w.x = cvt_pk_bf16(bflo(uw.x) * (acc[0] + bias), bfhi(uw.x) * (acc[1] + bias)); w.y = cvt_pk_bf16(bflo(uw.y) * (acc[2] + bias), bfhi(uw.y) * (acc[3] + bias));
            *(u32x2*)(HEADS + (size_t)row * D + col) = w;
        }
    }
    __syncthreads();
}

__device__ __forceinline__ void gmlp_block(LAS unsigned char* lds, const GAS bf16* U, const GAS bf16* VG, const GAS float* lnp, const GAS float* ln_g, const GAS float* ln_b, const GAS bf16* WSB,
                                           const GAS float* bsv, GAS bf16* HEADS, int first, int stride, int tid) {
    LAS bf16* VnT = (LAS bf16*)lds;
    const int lane = tid & 63, wave = __builtin_amdgcn_readfirstlane(tid >> 6), fr = lane & 15, fq = lane >> 4;
    const int s = tid & 127, cq = tid >> 7;
    if (first >= 1536) return;
    u32x4 vw[4]; f32x4 st[6];
#define GM_LOAD(unit_) do { const int g_ = (unit_) % 6, row_ = ((unit_) / 6) * 128 + s; const GAS f32x4* lp_ = (const GAS f32x4*)(lnp + (size_t)row_ * 24); \
        _Pragma("unroll") for (int i = 0; i < 6; ++i) st[i] = lp_[i]; \
        _Pragma("unroll") for (int i = 0; i < 4; ++i) vw[i] = *(const GAS u32x4*)(VG + (size_t)row_ * DT + g_ * 128 + cq * 32 + i * 8); } while (0)
    int unit = first;
    GM_LOAD(unit);
    for (;;) {
        const int g = unit % 6, row0 = (unit / 6) * 128;
        {
            float s1 = 0.f, s2 = 0.f;
#pragma unroll
            for (int i = 0; i < 6; ++i) { s1 += st[i].x + st[i].z; s2 += st[i].y + st[i].w; }
            const float mu = s1 * (1.0f / 768.0f), var = s2 * (1.0f / 768.0f) - mu * mu, rstd = __builtin_amdgcn_rsqf(var + EPS);
#pragma unroll
            for (int i = 0; i < 4; ++i) { const unsigned ww[4] = {vw[i].x, vw[i].y, vw[i].z, vw[i].w}; const int cb = g * 128 + cq * 32 + i * 8;
                const f32x4 g0 = *(const GAS f32x4*)(ln_g + cb), g1 = *(const GAS f32x4*)(ln_g + cb + 4), b0 = *(const GAS f32x4*)(ln_b + cb), b1 = *(const GAS f32x4*)(ln_b + cb + 4);
                const float gg[8] = {g0.x, g0.y, g0.z, g0.w, g1.x, g1.y, g1.z, g1.w}, bb[8] = {b0.x, b0.y, b0.z, b0.w, b1.x, b1.y, b1.z, b1.w};
#pragma unroll
                for (int j = 0; j < 4; ++j) { const int c = cq * 32 + i * 8 + j * 2;
                    const float x0 = (bflo(ww[j]) - mu) * rstd * gg[2 * j] + bb[2 * j], x1 = (bfhi(ww[j]) - mu) * rstd * gg[2 * j + 1] + bb[2 * j + 1];
                    const unsigned pk = cvt_pk_bf16(x0, x1); VnT[c * 136 + s] = (bf16)(pk & 0xffffu); VnT[(c + 1) * 136 + s] = (bf16)(pk >> 16); } }
        }
        __syncthreads();
        const int t = wave * 16 + fr, row = row0 + t;
        bf16x8 wf[4]; u32x2 uw[8];
#pragma unroll
        for (int ks = 0; ks < 4; ++ks) wf[ks] = *(const GAS bf16x8*)(WSB + (size_t)g * 16384 + t * 128 + ks * 32 + 8 * fq);
        const float bias = bsv[g * 128 + t];
#pragma unroll
        for (int ct = 0; ct < 8; ++ct) uw[ct] = *(const GAS u32x2*)(U + (size_t)row * DT + g * 128 + ct * 16 + 4 * fq);
        const int next = unit + stride; const bool has_next = next < 1536;
        if (has_next) GM_LOAD(next);
#pragma unroll
        for (int ct = 0; ct < 8; ++ct) {
            f32x4 acc = (f32x4){0.f, 0.f, 0.f, 0.f};
#pragma unroll
            for (int ks = 0; ks < 4; ++ks) { const bf16x8 a = *(const LAS bf16x8*)(VnT + (ct * 16 + fr) * 136 + ks * 32 + 8 * fq); acc = __builtin_amdgcn_mfma_f32_16x16x32_bf16(a, wf[ks], acc, 0, 0, 0); }
            u32x2 w; w.x = cvt_pk_bf16(bflo(uw[ct].x) * (acc[0] + bias), bfhi(uw[ct].x) * (acc[1] + bias)); w.y = cvt_pk_bf16(bflo(uw[ct].y) * (acc[2] + bias), bfhi(uw[ct].y) * (acc[3] + bias));
            *(GAS u32x2*)(HEADS + (size_t)row * D + g * 128 + ct * 16 + 4 * fq) = w;
        }
        __syncthreads();
        if (!has_next) break;
        unit = next;
    }
#undef GM_LOAD
}

__device__ __forceinline__ void hgrn_mfma_unit(LAS unsigned char* lds, const bf16* Q, bf16* Q2o, const float* LF, const bf16* V, bf16* HEADS, float* Ubuf, float* Dbuf, int unit, int tid) {
    constexpr int BUFB = 38400, OFF_KP = 8704, OFF_KH = 17408, OFF_VT = 27648, OFF_DD = 37888, OFF_O = 76800, OFF_TOT = 93696;
    const int lane = tid & 63, wave = __builtin_amdgcn_readfirstlane(tid >> 6), fr = lane & 15, fq = lane >> 4;
    const int seg = unit & 3, bh = unit >> 2, h = bh % 6, b = bh / 6, c0 = seg * 32;
    float run = 0.f;
    const int k = tid & 127, tq = tid >> 7;
    const int nt = tid >> 4, nsub = tid & 15;
    LAS float* OB = (LAS float*)(lds + OFF_O); LAS float* TOT = (LAS float*)(lds + OFF_TOT);
    f32x4 S[8];
#pragma unroll
    for (int i = 0; i < 8; ++i) S[i] = (f32x4){0.f, 0.f, 0.f, 0.f};
    float lfv[8], cs[8]; unsigned short qv[8], vv[8];
    const size_t colb = (size_t)h * 128 + k;
#define HG_LOAD(c) do { const size_t r0_ = (size_t)(b * SEQ + (c0 + (c)) * 32 + 8 * tq) * DT + colb; _Pragma("unroll") for (int j = 0; j < 8; ++j) { lfv[j] = LF[r0_ + (size_t)j * DT]; qv[j] = Q[r0_ + (size_t)j * DT]; vv[j] = V[r0_ + (size_t)j * DT]; } } while (0)
#define HG_PREP1() do { float c_ = 0.f; _Pragma("unroll") for (int j = 0; j < 8; ++j) { c_ += lfv[j]; cs[j] = c_; } TOT[tq * 128 + k] = c_; } while (0)
#define HG_PREP2(p, c) do { LAS unsigned char* B_ = lds + (p) * BUFB; const size_t r0_ = (size_t)(b * SEQ + (c0 + (c)) * 32 + 8 * tq) * DT + colb; LAS bf16* QT_ = (LAS bf16*)B_; LAS bf16* KP_ = (LAS bf16*)(B_ + OFF_KP); \
        const float t0_ = TOT[k], t1_ = TOT[128 + k], t2_ = TOT[256 + k], t3_ = TOT[384 + k]; \
        const float pre_ = tq == 0 ? 0.f : (tq == 1 ? t0_ : (tq == 2 ? t0_ + t1_ : (t0_ + t1_) + t2_)), bl_ = ((t0_ + t1_) + t2_) + t3_; \
        float kh_[8]; \
        _Pragma("unroll") for (int j = 0; j < 8; ++j) { const float bj_ = pre_ + cs[j], kk_ = 1.0f - __expf(lfv[j]); \
            const float qf_ = bf2f(qv[j]); QT_[(8 * tq + j) * 136 + k] = f2bf(qf_ * __expf(bj_)); Q2o[r0_ + (size_t)j * DT] = f2bf(qf_ * __expf(bj_ + run)); KP_[(8 * tq + j) * 136 + k] = f2bf(kk_ * __expf(fminf(-bj_, 70.0f))); kh_[j] = kk_ * __expf(bl_ - bj_); } \
        u32x4 w_; w_.x = cvt_pk_bf16(kh_[0], kh_[1]); w_.y = cvt_pk_bf16(kh_[2], kh_[3]); w_.z = cvt_pk_bf16(kh_[4], kh_[5]); w_.w = cvt_pk_bf16(kh_[6], kh_[7]); \
        *(LAS u32x4*)(B_ + OFF_KH + (k * 40 + 8 * tq) * 2) = w_; \
        u32x4 x_; x_.x = (unsigned)vv[0] | ((unsigned)vv[1] << 16); x_.y = (unsigned)vv[2] | ((unsigned)vv[3] << 16); x_.z = (unsigned)vv[4] | ((unsigned)vv[5] << 16); x_.w = (unsigned)vv[6] | ((unsigned)vv[7] << 16); \
        *(LAS u32x4*)(B_ + OFF_VT + (k * 40 + 8 * tq) * 2) = x_; \
        if (tq == 0) *(LAS float*)(B_ + OFF_DD + k * 4) = __expf(bl_); run += bl_; } while (0)
    HG_LOAD(0); HG_PREP1(); __syncthreads(); HG_PREP2(0, 0); __syncthreads();
    for (int c = 0; c < 32; ++c) {
        const int p = c & 1; const bool more = c + 1 < 32;
        if (more) HG_LOAD(c + 1);
        {
            LAS unsigned char* Bp = lds + p * BUFB; LAS bf16* QT = (LAS bf16*)Bp; LAS bf16* KP = (LAS bf16*)(Bp + OFF_KP); LAS bf16* KH = (LAS bf16*)(Bp + OFF_KH); LAS bf16* VT = (LAS bf16*)(Bp + OFF_VT);
            LAS float* DD = (LAS float*)(Bp + OFF_DD);
            f32x4 pt00 = (f32x4){0.f, 0.f, 0.f, 0.f}, pt01 = pt00, pt11 = pt00, o0 = pt00, o1 = pt00;
#pragma unroll
            for (int ks = 0; ks < 4; ++ks) {
                const bf16x8 a0 = *(const LAS bf16x8*)(KP + fr * 136 + 32 * ks + 8 * fq), a1 = *(const LAS bf16x8*)(KP + (16 + fr) * 136 + 32 * ks + 8 * fq);
                const bf16x8 b0 = *(const LAS bf16x8*)(QT + fr * 136 + 32 * ks + 8 * fq), b1 = *(const LAS bf16x8*)(QT + (16 + fr) * 136 + 32 * ks + 8 * fq);
                pt00 = __builtin_amdgcn_mfma_f32_16x16x32_bf16(a0, b0, pt00, 0, 0, 0); pt01 = __builtin_amdgcn_mfma_f32_16x16x32_bf16(a0, b1, pt01, 0, 0, 0); pt11 = __builtin_amdgcn_mfma_f32_16x16x32_bf16(a1, b1, pt11, 0, 0, 0);
            }
#pragma unroll
            for (int ks = 0; ks < 4; ++ks) {
                u32x4 sw; sw.x = cvt_pk_bf16(S[2 * ks][0], S[2 * ks][1]); sw.y = cvt_pk_bf16(S[2 * ks][2], S[2 * ks][3]); sw.z = cvt_pk_bf16(S[2 * ks + 1][0], S[2 * ks + 1][1]); sw.w = cvt_pk_bf16(S[2 * ks + 1][2], S[2 * ks + 1][3]);
                const bf16x8 sb = __builtin_bit_cast(bf16x8, sw);
                { const u32x2 e0 = *(const LAS u32x2*)(QT + fr * 136 + 32 * ks + 4 * fq), e1 = *(const LAS u32x2*)(QT + fr * 136 + 32 * ks + 16 + 4 * fq); u32x4 aw; aw.x = e0.x; aw.y = e0.y; aw.z = e1.x; aw.w = e1.y;
                  o0 = __builtin_amdgcn_mfma_f32_16x16x32_bf16(__builtin_bit_cast(bf16x8, aw), sb, o0, 0, 0, 0); }
                { const u32x2 e0 = *(const LAS u32x2*)(QT + (16 + fr) * 136 + 32 * ks + 4 * fq), e1 = *(const LAS u32x2*)(QT + (16 + fr) * 136 + 32 * ks + 16 + 4 * fq); u32x4 aw; aw.x = e0.x; aw.y = e0.y; aw.z = e1.x; aw.w = e1.y;
                  o1 = __builtin_amdgcn_mfma_f32_16x16x32_bf16(__builtin_bit_cast(bf16x8, aw), sb, o1, 0, 0, 0); }
            }
            {
#pragma unroll
                for (int r = 0; r < 4; ++r) { const bool keep = (4 * fq + r) <= fr; pt00[r] = keep ? pt00[r] : 0.f; pt11[r] = keep ? pt11[r] : 0.f; }
                u32x4 pa0; pa0.x = cvt_pk_bf16(pt00[0], pt00[1]); pa0.y = cvt_pk_bf16(pt00[2], pt00[3]); pa0.z = 0u; pa0.w = 0u;
                u32x4 pa1; pa1.x = cvt_pk_bf16(pt01[0], pt01[1]); pa1.y = cvt_pk_bf16(pt01[2], pt01[3]); pa1.z = cvt_pk_bf16(pt11[0], pt11[1]); pa1.w = cvt_pk_bf16(pt11[2], pt11[3]);
                const u32x2 v0 = *(const LAS u32x2*)(VT + (16 * wave + fr) * 40 + 4 * fq), v1 = *(const LAS u32x2*)(VT + (16 * wave + fr) * 40 + 16 + 4 * fq); u32x4 vw; vw.x = v0.x; vw.y = v0.y; vw.z = v1.x; vw.w = v1.y;
                const bf16x8 vb = __builtin_bit_cast(bf16x8, vw);
                o0 = __builtin_amdgcn_mfma_f32_16x16x32_bf16(__builtin_bit_cast(bf16x8, pa0), vb, o0, 0, 0, 0);
                o1 = __builtin_amdgcn_mfma_f32_16x16x32_bf16(__builtin_bit_cast(bf16x8, pa1), vb, o1, 0, 0, 0);
            }
#pragma unroll
            for (int r = 0; r < 4; ++r) { OB[(4 * fq + r) * 132 + 16 * wave + fr] = o0[r]; OB[(16 + 4 * fq + r) * 132 + 16 * wave + fr] = o1[r]; }
            {
                const bf16x8 vn = *(const LAS bf16x8*)(VT + (16 * wave + fr) * 40 + 8 * fq);
#pragma unroll
                for (int kt = 0; kt < 8; ++kt) { const bf16x8 ka = *(const LAS bf16x8*)(KH + (16 * kt + fr) * 40 + 8 * fq); const f32x4 dd = *(const LAS f32x4*)(DD + 16 * kt + 4 * fq);
                    S[kt] = __builtin_amdgcn_mfma_f32_16x16x32_bf16(ka, vn, S[kt] * dd, 0, 0, 0); }
            }
        }
        if (more) HG_PREP1();
        __syncthreads();
        if (more) HG_PREP2(p ^ 1, c + 1);
        {
            const f32x4 x0 = *(const LAS f32x4*)(OB + nt * 132 + nsub * 8), x1 = *(const LAS f32x4*)(OB + nt * 132 + nsub * 8 + 4);
            u32x4 r; r.x = cvt_pk_bf16(x0[0], x0[1]); r.y = cvt_pk_bf16(x0[2], x0[3]); r.z = cvt_pk_bf16(x1[0], x1[1]); r.w = cvt_pk_bf16(x1[2], x1[3]);
            *(u32x4*)(HEADS + (size_t)(b * SEQ + (c0 + c) * 32 + nt) * D + h * 128 + nsub * 8) = r;
        }
        __syncthreads();
    }
#pragma unroll
    for (int kt = 0; kt < 8; ++kt)
#pragma unroll
        for (int r = 0; r < 4; ++r) Ubuf[(size_t)unit * 16384 + (16 * kt + 4 * fq + r) * 128 + 16 * wave + fr] = S[kt][r];
    if (tq == 0) Dbuf[unit * 128 + k] = __expf(run);
#undef HG_LOAD
#undef HG_PREP1
#undef HG_PREP2
}

__device__ __forceinline__ void hgrn_fix_stage(LAS bf16* ST, const float* Ubuf, const float* Dbuf, int unit, int tid) {
    const int seg = unit & 3, bh = unit >> 2;
    if (seg > 0) {
        const int k = tid >> 2, v0 = (tid & 3) * 32;
        const float* U0 = Ubuf + (size_t)(bh * 4) * 16384 + k * 128 + v0;
        const float d1 = Dbuf[(bh * 4 + 1) * 128 + k], d2 = Dbuf[(bh * 4 + 2) * 128 + k];
#pragma unroll
        for (int i = 0; i < 8; ++i) {
            f32x4 s = *(const f32x4*)(U0 + 4 * i);
            if (seg > 1) s = s * d1 + *(const f32x4*)(U0 + 16384 + 4 * i);
            if (seg > 2) s = s * d2 + *(const f32x4*)(U0 + 2 * 16384 + 4 * i);
#pragma unroll
            for (int j = 0; j < 4; ++j) ST[(v0 + 4 * i + j) * 136 + k] = f2bf(s[j]);
        }
    }
}
__device__ __forceinline__ void hgrn_fix_block(LAS unsigned char* lds, const bf16* Q2, bf16* HEADS, const bf16* Gg, const float* Ubuf, const float* Dbuf, int blk, int tid) {
    const int lane = tid & 63, wave = __builtin_amdgcn_readfirstlane(tid >> 6), fr = lane & 15, fq = lane >> 4;
    const int u0 = (blk * 6) >> 3, u1 = (blk * 6 + 5) >> 3;
    hgrn_fix_stage((LAS bf16*)lds, Ubuf, Dbuf, u0, tid);
    if (u1 != u0) hgrn_fix_stage((LAS bf16*)lds + 128 * 136, Ubuf, Dbuf, u1, tid);
    __syncthreads();
    if (wave < 6) {
        const int sl = blk * 6 + wave, unit = sl >> 3, part = sl & 7;
        const LAS bf16* ST = (const LAS bf16*)lds + (unit != u0 ? 128 * 136 : 0);
        const int seg = unit & 3, bh = unit >> 2, h = bh % 6, b = bh / 6;
        for (int tt = 0; tt < 8; ++tt) {
            const size_t row = (size_t)b * SEQ + seg * 1024 + part * 128 + tt * 16 + fr;
            f32x4 acc[8];
#pragma unroll
            for (int vt = 0; vt < 8; ++vt) acc[vt] = (f32x4){0.f, 0.f, 0.f, 0.f};
            if (seg > 0) {
                bf16x8 qb[4];
#pragma unroll
                for (int ks = 0; ks < 4; ++ks) qb[ks] = *(const bf16x8*)(Q2 + row * DT + h * 128 + 32 * ks + 8 * fq);
#pragma unroll
                for (int vt = 0; vt < 8; ++vt)
#pragma unroll
                    for (int ks = 0; ks < 4; ++ks) { const bf16x8 a = *(const LAS bf16x8*)(ST + (16 * vt + fr) * 136 + 32 * ks + 8 * fq); acc[vt] = __builtin_amdgcn_mfma_f32_16x16x32_bf16(a, qb[ks], acc[vt], 0, 0, 0); }
            }
            float ss = 0.f;
#pragma unroll
            for (int vt = 0; vt < 8; ++vt) { const u32x2 ow = *(const u32x2*)(HEADS + row * D + h * 128 + 16 * vt + 4 * fq);
                acc[vt][0] += bflo(ow.x); acc[vt][1] += bfhi(ow.x); acc[vt][2] += bflo(ow.y); acc[vt][3] += bfhi(ow.y);
                ss += (acc[vt][0] * acc[vt][0] + acc[vt][1] * acc[vt][1]) + (acc[vt][2] * acc[vt][2] + acc[vt][3] * acc[vt][3]); }
            ss += __shfl_xor(ss, 16); ss += __shfl_xor(ss, 32);
            const float rs = rsqrtf(ss * (1.0f / 128.0f) + EPS);
#pragma unroll
            for (int vt = 0; vt < 8; ++vt) { const u32x2 gw = *(const u32x2*)(Gg + row * DT + h * 128 + 16 * vt + 4 * fq);
                u32x2 w; w.x = cvt_pk_bf16(acc[vt][0] * rs * bflo(gw.x), acc[vt][1] * rs * bfhi(gw.x)); w.y = cvt_pk_bf16(acc[vt][2] * rs * bflo(gw.y), acc[vt][3] * rs * bfhi(gw.y));
                *(u32x2*)(HEADS + row * D + h * 128 + 16 * vt + 4 * fq) = w; }
        }
    }
    __syncthreads();
}

#define XB_TMO      128
#define XB_XCNT(j)  (256  + 64 * (j))
#define XB_XSUB(j)  (1280 + 64 * (j))
#define XB_XGEN(j)  (2304 + 64 * (j))
#define XB_TOP      3328
#define XB_TOPGEN   3392
#define XCD_BAR_WORDS 3456
#define XB_SPIN_CAP (1u << 18)

__device__ __forceinline__ unsigned xb_ld(unsigned* p)              { return __hip_atomic_load(p, __ATOMIC_RELAXED, __HIP_MEMORY_SCOPE_AGENT); }
__device__ __forceinline__ unsigned xb_add(unsigned* p, unsigned v) { return __hip_atomic_fetch_add(p, v, __ATOMIC_RELAXED, __HIP_MEMORY_SCOPE_AGENT); }
__device__ __forceinline__ unsigned xb_xcc_id() { return (unsigned)__builtin_amdgcn_s_getreg((3 << 11) | 20) & 0xFu; }
#define XB_SPIN(cond, bar) do { unsigned _sp = 0; while (cond) { __builtin_amdgcn_s_sleep(1); \
    if ((++_sp & 255u) == 0u) { if (xb_ld(&(bar)[XB_TMO])) break; if (_sp > XB_SPIN_CAP) { atomicAdd(&(bar)[XB_TMO], 1u); break; } } } } while (0)

struct XcdBarrier {
    unsigned* bar; unsigned x;
    volatile LAS unsigned* st;
};

__device__ __forceinline__ XcdBarrier xcd_barrier_post(unsigned* bar, volatile LAS unsigned* st) {
    XcdBarrier b; b.bar = bar; b.x = xb_xcc_id(); b.st = st;
    if (threadIdx.x == 0) (void)xb_add(&bar[XB_XCNT(b.x)], 1u);
    return b;
}
__device__ __forceinline__ void xcd_barrier_complete(unsigned* bar, unsigned x, unsigned& nloc, unsigned& nx) {
    const unsigned G = gridDim.x * gridDim.y * gridDim.z;
    unsigned sum, cnt, mine, sp = 0u;
    for (;;) {
        sum = 0u; cnt = 0u; mine = 0u;
#pragma unroll
        for (unsigned j = 0; j < 16; ++j) { const unsigned c = xb_ld(&bar[XB_XCNT(j)]); sum += c; cnt += (c > 0u) ? 1u : 0u; mine = (j == x) ? c : mine; }
        if (sum == G) break;
        __builtin_amdgcn_s_sleep(1);
        if ((++sp & 255u) == 0u) { if (xb_ld(&bar[XB_TMO])) break; if (sp > XB_SPIN_CAP) { atomicAdd(&bar[XB_TMO], 1u); break; } }
    }
    nloc = mine > 0u ? mine : 1u; nx = cnt > 0u ? cnt : 1u;
}

__device__ __forceinline__ void xcd_barrier(const XcdBarrier& b) {
    asm volatile("s_waitcnt vmcnt(0)" ::: "memory");
    __syncthreads();
    if (threadIdx.x == 0) {
        unsigned* bar = b.bar;
        __builtin_amdgcn_s_waitcnt(0);
        unsigned nloc = b.st[0], nx = b.st[1];
        if (nloc == 0u) { xcd_barrier_complete(bar, b.x, nloc, nx); b.st[0] = nloc; b.st[1] = nx; }
        const unsigned old = xb_add(&bar[XB_XSUB(b.x)], 1u);
        const unsigned gen = old / nloc;
        if (old + 1u == (gen + 1u) * nloc) {
            __builtin_amdgcn_fence(__ATOMIC_RELEASE, "agent");
            asm volatile("s_waitcnt vmcnt(0)" ::: "memory");
            const unsigned og = xb_add(&bar[XB_TOP], 1u);
            const unsigned tg = og / nx;
            if (og + 1u == (tg + 1u) * nx) xb_add(&bar[XB_TOPGEN], 1u);
            else XB_SPIN(xb_ld(&bar[XB_TOPGEN]) == tg, bar);
            __builtin_amdgcn_fence(__ATOMIC_ACQUIRE, "agent");
            xb_add(&bar[XB_XGEN(b.x)], 1u);
            asm volatile("s_waitcnt vmcnt(0)" ::: "memory");
        } else {
            XB_SPIN(xb_ld(&bar[XB_XGEN(b.x)]) == gen, bar);
            __builtin_amdgcn_fence(__ATOMIC_ACQUIRE, "agent");
            asm volatile("s_waitcnt vmcnt(0)" ::: "memory");
        }
    }
    __syncthreads();
}


#define PHASE_BEGIN unsigned char* ws = a.ws; asm volatile("" : "+s"(ws)); int tid = threadIdx.x; asm volatile("" : "+v"(tid)); const int lane = tid & 63, wave = __builtin_amdgcn_readfirstlane(tid >> 6); (void)lane; (void)wave; (void)ws;
#define WSP(T, off) ((T*)(ws + (off)))
#define GSYNC() do { xcd_barrier(xbar); if (PROBE == 3) { xcd_barrier(xbar); xcd_barrier(xbar); xcd_barrier(xbar); } } while (0)
__global__ void __launch_bounds__(512, 2) fwd_megakernel(Args a) {
    extern __shared__ __attribute__((aligned(16))) unsigned char lds_raw[];
    LAS unsigned char* lds = (LAS unsigned char*)lds_raw;
    cg::grid_group grid = cg::this_grid();
    const int G = gridDim.x, bx = blockIdx.x;
    if (threadIdx.x < 4) ((LAS unsigned*)(lds + 131072 + 64))[threadIdx.x] = 0u;
    __syncthreads();
    XcdBarrier xbar = xcd_barrier_post((unsigned*)(a.ws + WS_BAR), (volatile LAS unsigned*)(lds + 131072 + 64));

    for (int rep_ = 0; rep_ < (PROBE == 4 ? 2 : 1); ++rep_) {
        PHASE_BEGIN
        const float* x = a.in[0]; const float* mem = a.in[1]; const float* mix_norm = a.in[2]; const float* mem_norm = a.in[3]; const float* w_mem_kv = a.in[4];
        const float* hg_w_in = a.in[6]; const float* hg_lb = a.in[7]; const float* gm_ws = a.in[12];
        bf16* WinA = WSP(bf16, WS_WINA);
        bf16* Wkv = WSP(bf16, WS_WKV); bf16* WSB = WSP(bf16, WS_WSB); float* LB = WSP(float, WS_MISC); float* SS = WSP(float, WS_PART); float* MSS = WSP(float, WS_MPART);
        bf16* MEMB = WSP(bf16, WS_MEMB); bf16* XB = WSP(bf16, WS_XB);
        LAS float* scr = (LAS float*)(lds + wave * 16384);
        const int gw = bx * 8 + wave, NGW = G * 8;
        convert_matrix(hg_w_in, D, NA, mix_norm, WinA, false, 0, gw, NGW, scr, lane);
        convert_matrix(w_mem_kv, D, 512, mem_norm, Wkv, false, 0, gw, NGW, scr, lane);
        convert_matrix(w_mem_kv + (size_t)D * 512, D, 512, mem_norm + D, Wkv, false, 512, gw, NGW, scr, lane);
        for (int m = gw * 4; m < M; m += NGW * 4) rows_to_bf16<4>(x + (size_t)m * D, XB + (size_t)m * D, SS + m, lane);
        for (int m = gw; m < MM; m += NGW) rows_to_bf16<1>(mem + (size_t)m * D, MEMB + (size_t)m * D, MSS + m, lane);
        for (int i = bx * 512 + tid; i < 4 * M; i += G * 512) SS[M + i] = 0.f;
        for (int i = bx * 512 + tid; i < 6 * 128 * 128; i += G * 512) { const int s = i & 127, t = (i >> 7) & 127; WSB[i] = f2bf(s <= t ? gm_ws[i] : 0.f); }
        if (bx == 0) for (int c = tid; c < DT; c += 512) { const float a0 = hg_lb[c], a1 = hg_lb[DT + c], a2 = hg_lb[2 * DT + c]; const float mx = fmaxf(a0, fmaxf(a1, a2));
            const float e0 = __expf(a0 - mx), e1 = __expf(a1 - mx), e2 = __expf(a2 - mx); LB[c] = e0 / (e0 + e1 + e2); }
    }
    grid.sync();

    for (int layer = 0; layer < 2; ++layer) {
        if (layer == 0) {
#ifndef SKIP_G1A
            for (int rep_ = 0; rep_ < (PROBE == 6 ? 2 : 1); ++rep_)
            { PHASE_BEGIN
              pg8::Gemm g{WSP(bf16, WS_XB), WSP(bf16, WS_WINA), M, NA, D}; RsOrder S; S.init(M, NA, G, bx); S.ss = (const GAS float*)WSP(float, WS_PART); S.pa = 0.f; S.pb = 0.f; S.nth = 0;
              EpiProjA E{&S, (LAS float*)(lds + 131072 + 1024), (GAS bf16*)WSP(bf16, WS_Q), (GAS float*)WSP(float, WS_LF), (GAS bf16*)WSP(bf16, WS_V), (GAS bf16*)WSP(bf16, WS_G), (GAS bf16*)WSP(bf16, WS_QM), (const GAS float*)WSP(float, WS_MISC), (const GAS float*)a.in[8]};
              pg8::gemm_phase<EpiProjA, RsOrder, true, true>(lds, g, S, E); }
#endif
#ifndef SKIP_KV
            { PHASE_BEGIN
              pg8::Gemm g{WSP(bf16, WS_MEMB), WSP(bf16, WS_WKV), MM, 1024, D}; RsOrder S; S.init(MM, 1024, G, (bx + 128) % G); S.ss = (const GAS float*)WSP(float, WS_MPART); S.pa = 0.f; S.pb = 0.f; S.nth = 0;
              EpiKV E{&S, (LAS float*)(lds + 131072 + 1024), (GAS bf16*)WSP(bf16, WS_KV)};
              pg8::gemm_phase<EpiKV, RsOrder, true, true>(lds, g, S, E); }
#endif
            if (bx >= 160) { PHASE_BEGIN
              convert_group(a, ws, 1, (bx - 160) * 8 + wave, (G - 160) * 8, (LAS float*)(lds + wave * 16384), lane); }
        } else {
#ifndef SKIP_G1B
            for (int rep_ = 0; rep_ < (PROBE == 7 ? 2 : 1); ++rep_) {
            PHASE_BEGIN
            pg8::Gemm g{WSP(bf16, WS_XB), WSP(bf16, WS_WINB), M, NBW, D}; RsOrder S; S.init(M, NBW, G, bx); S.ss = (const GAS float*)(WSP(float, WS_PART) + 2 * M); S.pa = 0.f; S.pb = 0.f; S.nth = 0;
            EpiProjB E{&S, (LAS float*)(lds + 131072 + 1024), (GAS bf16*)WSP(bf16, WS_Q), (GAS bf16*)WSP(bf16, WS_V), (GAS bf16*)WSP(bf16, WS_QM), (GAS float*)WSP(float, WS_LNP)};
            pg8::gemm_phase<EpiProjB, RsOrder, true, true>(lds, g, S, E); }
#endif
            if (bx >= 128) { PHASE_BEGIN
              convert_group(a, ws, 2, (bx - 128) * 8 + wave, (G - 128) * 8, (LAS float*)(lds + wave * 16384), lane); }
        }
        GSYNC();
        if (layer == 0) {
            { PHASE_BEGIN
#ifndef SKIP_HG
              if (bx < 192) hgrn_mfma_unit(lds, WSP(bf16, WS_Q), (bf16*)a.out, WSP(float, WS_LF), WSP(bf16, WS_V), WSP(bf16, WS_HEADS), WSP(float, WS_XB), WSP(float, WS_XB + 16 * MiB), bx, tid);
#endif
#ifndef SKIP_MA
              if (bx >= 192) memattn_block(lds, (const GAS bf16*)WSP(bf16, WS_QM), (const GAS bf16*)WSP(bf16, WS_KV), (GAS bf16*)WSP(bf16, WS_HEADS), 0, bx - 192, G - 192, 512, tid);
#endif
            }
            GSYNC();
            { PHASE_BEGIN
#ifndef SKIP_HG
              hgrn_fix_block(lds, (const bf16*)a.out, WSP(bf16, WS_HEADS), WSP(bf16, WS_G), WSP(float, WS_XB), WSP(float, WS_XB + 16 * MiB), bx, tid);
#endif
            }
        } else {
            PHASE_BEGIN
            for (int rep_ = 0; rep_ < (PROBE == 5 ? 2 : 1); ++rep_) {
#ifndef SKIP_GM
                gmlp_block(lds, (const GAS bf16*)WSP(bf16, WS_Q), (const GAS bf16*)WSP(bf16, WS_V), (const GAS float*)WSP(float, WS_LNP), (const GAS float*)a.in[10], (const GAS float*)a.in[11],
                           (const GAS bf16*)WSP(bf16, WS_WSB), (const GAS float*)a.in[13], (GAS bf16*)WSP(bf16, WS_HEADS), bx, G, tid);
#endif
#ifndef SKIP_MA
                memattn_block(lds, (const GAS bf16*)WSP(bf16, WS_QM), (const GAS bf16*)WSP(bf16, WS_KV), (GAS bf16*)WSP(bf16, WS_HEADS), 1, bx, G, 512, tid);
#endif
            }
        }
        GSYNC();
#ifndef SKIP_G2
        { PHASE_BEGIN
          pg8::Gemm g{WSP(bf16, WS_HEADS), WSP(bf16, WS_WOUT) + (size_t)layer * D * D, M, D, D}; pg8::StaticOrder S; S.init(M, D, G, bx);
          EpiRes E{layer == 0 ? (const GAS float*)a.in[0] : (const GAS float*)nullptr, nullptr, (GAS bf16*)WSP(bf16, WS_XB), (GAS float*)(WSP(float, WS_PART) + (size_t)(1 + 2 * layer) * M)};
          pg8::gemm_phase<EpiRes, pg8::StaticOrder, true, true>(lds, g, S, E); }
#endif
        GSYNC();
#ifndef SKIP_G3
        for (int rep_ = 0; rep_ < (PROBE == 2 ? 2 : 1); ++rep_)
        { PHASE_BEGIN
          pg8::Gemm g{WSP(bf16, WS_XB), WSP(bf16, WS_WFFI) + (size_t)layer * NF * D, M, NF, D}; RsOrder S; S.init(M, NF, G, bx); S.ss = (const GAS float*)(WSP(float, WS_PART) + (size_t)(1 + 2 * layer) * M); S.pa = 0.f; S.pb = 0.f; S.nth = 0;
          EpiFfn E{&S, (LAS float*)(lds + 131072 + 1024), (GAS bf16*)WSP(bf16, WS_ACT)};
          pg8::gemm_phase<EpiFfn, RsOrder, true, true>(lds, g, S, E); }
#endif
        GSYNC();
#ifndef SKIP_G4
        { PHASE_BEGIN
          pg8::Gemm g{WSP(bf16, WS_ACT), WSP(bf16, WS_WFFO) + (size_t)layer * D * FF, M, D, FF}; ReverseOrder S; S.initr(M, D, G, bx);
          EpiRes E{nullptr, nullptr, (GAS bf16*)WSP(bf16, WS_XB), (GAS float*)(WSP(float, WS_PART) + (size_t)(2 + 2 * layer) * M)};
          pg8::gemm_phase<EpiRes, ReverseOrder, true, true>(lds, g, S, E); }
#endif
        GSYNC();
    }
    { PHASE_BEGIN
      const float* SS4 = WSP(float, WS_PART) + (size_t)4 * M; const bf16* XB = WSP(bf16, WS_XB); float* out = a.out; const float* final_norm = a.in[17];
      const int gw = bx * 8 + wave, NGW = G * 8;
      f32x4 gn[4];
#pragma unroll
      for (int j = 0; j < 4; ++j) gn[j] = ((const f32x4*)final_norm)[(j >> 1) * 128 + 2 * lane + (j & 1)];
      for (int m = gw * 4; m < M; m += NGW * 4) {
          u32x4 w[4][2]; float rs[4];
#pragma unroll
          for (int r = 0; r < 4; ++r) { rs[r] = row_rstd(SS4, m + r);
#pragma unroll
              for (int hh = 0; hh < 2; ++hh) w[r][hh] = __builtin_nontemporal_load((const u32x4*)(XB + (size_t)(m + r) * D) + hh * 64 + lane); }
#pragma unroll
          for (int r = 0; r < 4; ++r)
#pragma unroll
              for (int hh = 0; hh < 2; ++hh) { f32x4* o = (f32x4*)(out + (size_t)(m + r) * D) + hh * 128 + 2 * lane;
                  o[0] = (f32x4){bflo(w[r][hh].x), bfhi(w[r][hh].x), bflo(w[r][hh].y), bfhi(w[r][hh].y)} * rs[r] * gn[2 * hh];
                  o[1] = (f32x4){bflo(w[r][hh].z), bfhi(w[r][hh].z), bflo(w[r][hh].w), bfhi(w[r][hh].w)} * rs[r] * gn[2 * hh + 1]; } } }
}

extern "C" void kernel_launch(void* const* d_in, const int* in_sizes, int n_in, void* d_out, int out_size, void* d_ws, size_t ws_size, hipStream_t stream) {
    static int grid_blocks = 0;
    if (!grid_blocks) {
        if (n_in != 18 || out_size != M * D || ws_size < WS_END) { fprintf(stderr, "kernel_launch: unexpected shapes (n_in %d out %d ws %zu, need %zu)\n", n_in, out_size, ws_size, (size_t)WS_END); grid_blocks = -1; return; }
        int dev = 0, cus = 0, per_cu = 0;
        (void)hipGetDevice(&dev); (void)hipDeviceGetAttribute(&cus, hipDeviceAttributeMultiprocessorCount, dev);
        if (hipFuncSetAttribute((const void*)fwd_megakernel, hipFuncAttributeMaxDynamicSharedMemorySize, LDS_BYTES) != hipSuccess) fprintf(stderr, "kernel_launch: hipFuncSetAttribute failed\n");
        if (hipOccupancyMaxActiveBlocksPerMultiprocessor(&per_cu, fwd_megakernel, 512, LDS_BYTES) != hipSuccess || per_cu < 1) { fprintf(stderr, "kernel_launch: occupancy query gave %d\n", per_cu); per_cu = 1; }
        if (per_cu > 1) per_cu = 1;
        grid_blocks = cus * per_cu;
    }
    if (grid_blocks < 0) return;
    Args a{};
    for (int i = 0; i < 18; ++i) a.in[i] = (const float*)d_in[i];
    a.out = (float*)d_out; a.ws = (unsigned char*)d_ws;
    void* args[] = {&a};
    if (hipMemsetAsync((char*)d_ws + WS_BAR, 0, XCD_BAR_WORDS * 4, stream) != hipSuccess) fprintf(stderr, "kernel_launch: memset of barrier words failed\n");
    hipError_t e = hipLaunchCooperativeKernel((const void*)fwd_megakernel, dim3(grid_blocks), dim3(512), args, LDS_BYTES, stream);
    if (e != hipSuccess) fprintf(stderr, "cooperative launch failed: %s (grid %d)\n", hipGetErrorString(e), grid_blocks);
}
```

```cpp
#include <hip/hip_runtime.h>
#include <hip/hip_cooperative_groups.h>
#include <cstdio>
#include <cstdint>
namespace cg = cooperative_groups;
#ifndef PROBE
#define PROBE 0
#endif
namespace pg8 {
#define PG8_LAS __attribute__((address_space(3)))
typedef unsigned short bf16_t;
typedef short bf16x8 __attribute__((ext_vector_type(8)));
typedef float f32x4 __attribute__((ext_vector_type(4)));
typedef unsigned u32x4 __attribute__((ext_vector_type(4)));
constexpr int BM = 256, BK = 64, HALF = 128, HTB = HALF * BK * 2  , STAGE_BYTES = 8 * HTB, NXCD = 8, WGM = 8;

__host__ __device__ __forceinline__ int lds_byte(int r, int c) { const int st = (r >> 4) * 2 + (c >> 5), rr = r & 15, cc = c & 31, ob = rr * 64 + cc * 2; return st * 1024 + (ob ^ (((ob >> 9) & 1) << 5)); }
__host__ __device__ __forceinline__ void stage_rc(int b, int& R, int& C) { const int st = b / 1024, sb = b % 1024, swz = sb ^ (((sb >> 9) & 1) << 5); R = (st >> 1) * 16 + swz / 64; C = (st & 1) * 32 + (swz % 64) / 2; }
__host__ __device__ __forceinline__ int perm32(int rho) { const int n = rho >> 4, i = rho & 15; return 8 * (i >> 2) + 4 * n + (i & 3); }

struct Unit { int pm, pn; };
struct Gemm { const bf16_t* A; const bf16_t* Bt; int M, N, K; };

struct StaticOrder {
    int nM, nN, nwg, G, c;
    __host__ __device__ void init(int M, int N, int G_, int c_) { nM = M / BM; nN = N / BM; nwg = nM * nN; G = G_; c = c_; }
    __host__ __device__ bool next(int i, Unit& u) const {
        const long L = (long)i * G + c; if (L >= nwg) return false;
        int wgid = (int)L; { const int q = nwg / NXCD, r = nwg % NXCD, xcd = wgid % NXCD, off = wgid / NXCD; wgid = (xcd < r ? xcd * (q + 1) : r * (q + 1) + (xcd - r) * q) + off; }
        const int nig = WGM * nN, gid = wgid / nig, fm = gid * WGM, gsz = (nM - fm) < WGM ? (nM - fm) : WGM;
        u.pm = fm + ((wgid % nig) % gsz); u.pn = (wgid % nig) / gsz; return true;
    }
    __device__ __forceinline__ void a_ready(const Unit&) const {}
    __device__ __forceinline__ void done(const Unit&) const {}
    __device__ __forceinline__ void after_epi(const Unit&) const {}
};
__device__ __forceinline__ unsigned cvt_pk_bf16(float lo, float hi) { unsigned r; asm volatile("v_cvt_pk_bf16_f32 %0, %1, %2" : "=v"(r) : "v"(lo), "v"(hi)); return r; }
typedef float f32x2 __attribute__((ext_vector_type(2)));
__device__ __forceinline__ f32x2 gelu_pk(f32x2 v) {
    const f32x2 av = __builtin_elementwise_abs(v), d = av * 0.2316418882f + 1.0f;
    f32x2 t; t.x = __builtin_amdgcn_rcpf(d.x); t.y = __builtin_amdgcn_rcpf(d.y);
    f32x2 q = t * 0.5307027145f + (-0.7265760135f); q = q * t + 0.7107068705f; q = q * t + (-0.142248368f); q = q * t + 0.127414796f; q = q * t;
    const f32x2 s = (v * v) * (-0.72134752044f);
    f32x2 e; e.x = __builtin_amdgcn_exp2f(s.x); e.y = __builtin_amdgcn_exp2f(s.y);
    const f32x2 m = v * (q * e), r = v - m;
    f32x2 o; o.x = v.x < 0.f ? m.x : r.x; o.y = v.y < 0.f ? m.y : r.y; return o;
}
template <class Epi, class Sched, bool ALIGN_EPI = false, bool SP2 = false>
__device__ __forceinline__ void gemm_phase(PG8_LAS unsigned char* lds, const Gemm g, const Sched& S, const Epi& E) {
    int tid_ = threadIdx.x; asm volatile("" : "+v"(tid_));
    const int tid = tid_, wid = __builtin_amdgcn_readfirstlane(tid >> 6), lane = tid & 63, wr = wid >> 2, wc = wid & 3, fr = lane & 15, fq = lane >> 4;
    const int K = g.K, nt = K / BK;
    unsigned voffA[2], voffB[2];
#pragma unroll
    for (int i = 0; i < 2; ++i) { int R, C; stage_rc(tid * 16 + i * 8192, R, C); const int Rb = Epi::PERM ? ((R & ~31) + perm32(R & 31)) : R;
        voffA[i] = (unsigned)(R * K + C) * 2u; voffB[i] = (unsigned)(Rb * K + C) * 2u; }
    const size_t kstep = (size_t)(BK * 2);
    const size_t hstep = (size_t)HALF * K * 2;
    const size_t tstep = 2 * hstep;
    const unsigned ldsw = (unsigned)wid * 1024u;
    const int aoff = lds_byte(wr * 64 + fr, fq * 8), boff = lds_byte(wc * 32 + fr, fq * 8);
#define PG8_SA(b, h) (((b) * 2 + (h)) * HTB)
#define PG8_SB(b, h) ((4 + (b) * 2 + (h)) * HTB)
#define PG8_STAGE(bufoff, gbase, voff) do { _Pragma("unroll") for (int _i = 0; _i < 2; ++_i) \
        __builtin_amdgcn_global_load_lds((const unsigned*)((const char*)(gbase) + (voff)[_i]), (PG8_LAS unsigned*)(lds + (bufoff) + ldsw + _i * 8192), 16, 0, 0); } while (0)
#define PG8_LDA(dst, b, h) do { _Pragma("unroll") for (int m = 0; m < 4; ++m) _Pragma("unroll") for (int k = 0; k < 2; ++k) dst[m][k] = *(const PG8_LAS bf16x8*)(lds + PG8_SA(b, h) + aoff + m * 2048 + k * 1024); } while (0)
#define PG8_LDB(dst, b, h) do { _Pragma("unroll") for (int n = 0; n < 2; ++n) _Pragma("unroll") for (int k = 0; k < 2; ++k) dst[n][k] = *(const PG8_LAS bf16x8*)(lds + PG8_SB(b, h) + boff + n * 2048 + k * 1024); } while (0)
#define PG8_MMA(ai, bj, At, Bt) do { __builtin_amdgcn_s_setprio(1); _Pragma("unroll") for (int m = 0; m < 4; ++m) _Pragma("unroll") for (int n = 0; n < 2; ++n) _Pragma("unroll") for (int k = 0; k < 2; ++k) \
        acc[ai][bj][m][n] = __builtin_amdgcn_mfma_f32_16x16x32_bf16(Bt[n][k], At[m][k], acc[ai][bj][m][n], 0, 0, 0); __builtin_amdgcn_s_setprio(0); } while (0)
#define PG8_WAIT_V(n) asm volatile("s_waitcnt vmcnt(" #n ")" ::: "memory")
#define PG8_WAIT_L(n) asm volatile("s_waitcnt lgkmcnt(" #n ")" ::: "memory")
#define PG8_BAR __builtin_amdgcn_s_barrier()
#define PG8_SCHED __builtin_amdgcn_sched_barrier(0)
    Unit cur, nxt; int ui = 0;
    if (!S.next(0, cur)) return;
    f32x4 acc[2][2][4][2];
#pragma unroll
    for (int a = 0; a < 2; ++a)
#pragma unroll
        for (int b = 0; b < 2; ++b)
#pragma unroll
            for (int m = 0; m < 4; ++m)
#pragma unroll
                for (int n = 0; n < 2; ++n) acc[a][b][m][n] = (f32x4){0.f, 0.f, 0.f, 0.f};
    bf16x8 At[4][2], B0[2][2], B1[2][2];
    const char* cA = (const char*)g.A + (size_t)cur.pm * tstep; const char* cB = (const char*)g.Bt + (size_t)cur.pn * tstep;
    S.a_ready(cur); S.after_epi(cur);
    if constexpr (SP2) {
        PG8_STAGE(PG8_SB(0, 0), cB, voffB); PG8_STAGE(PG8_SB(0, 1), cB + hstep, voffB); PG8_STAGE(PG8_SA(0, 0), cA, voffA); PG8_STAGE(PG8_SA(0, 1), cA + hstep, voffA);
        if (wr == 1) PG8_BAR;
        PG8_WAIT_V(2); PG8_BAR;
        PG8_STAGE(PG8_SB(1, 0), cB + kstep, voffB); PG8_STAGE(PG8_SA(1, 0), cA + kstep, voffA); PG8_STAGE(PG8_SB(1, 1), cB + hstep + kstep, voffB);
        PG8_WAIT_V(6); PG8_BAR;
    } else {
        PG8_STAGE(PG8_SB(0, 0), cB, voffB); PG8_STAGE(PG8_SA(0, 0), cA, voffA); PG8_STAGE(PG8_SB(0, 1), cB + hstep, voffB); PG8_STAGE(PG8_SA(0, 1), cA + hstep, voffA);
        if (wr == 1) PG8_BAR;
        PG8_WAIT_V(4); PG8_BAR;
        PG8_STAGE(PG8_SB(1, 0), cB + kstep, voffB); PG8_STAGE(PG8_SA(1, 0), cA + kstep, voffA); PG8_STAGE(PG8_SB(1, 1), cB + hstep + kstep, voffB);
        PG8_WAIT_V(6); PG8_BAR;
    }
    for (;;) {
        const bool has_next = S.next(ui + 1, nxt);
        const char* nA = has_next ? (const char*)g.A + (size_t)nxt.pm * tstep : cA; const char* nB = has_next ? (const char*)g.Bt + (size_t)nxt.pn * tstep : cB;
        for (int t = 0; t < nt; t += 2) {
            const bool last = (t == nt - 2);
            const char* a1 = cA + (size_t)(t + 1) * kstep;
            const char* a2 = last ? nA : cA + (size_t)(t + 2) * kstep; const char* b2 = last ? nB : cB + (size_t)(t + 2) * kstep;
            const char* a3 = a2 + kstep; const char* b3 = b2 + kstep;
            if (last && has_next) S.a_ready(nxt);
            if constexpr (SP2) {
            PG8_LDB(B0, 0, 0); PG8_LDB(B1, 0, 1); PG8_SCHED; PG8_LDA(At, 0, 0); PG8_STAGE(PG8_SA(1, 1), a1 + hstep, voffA);
            PG8_WAIT_V(8); PG8_WAIT_L(0); PG8_BAR; PG8_MMA(0, 0, At, B0); PG8_MMA(0, 1, At, B1); PG8_BAR; PG8_SCHED;
            PG8_LDA(At, 0, 1); PG8_STAGE(PG8_SB(0, 0), b2, voffB); PG8_STAGE(PG8_SB(0, 1), b2 + hstep, voffB); PG8_STAGE(PG8_SA(0, 0), a2, voffA);
            PG8_WAIT_V(8); PG8_WAIT_L(0); PG8_BAR; PG8_MMA(1, 0, At, B0); PG8_MMA(1, 1, At, B1); PG8_BAR; PG8_SCHED;
            PG8_LDB(B0, 1, 0); PG8_LDB(B1, 1, 1); PG8_SCHED; PG8_LDA(At, 1, 0); PG8_STAGE(PG8_SA(0, 1), a2 + hstep, voffA);
            PG8_WAIT_V(8); PG8_WAIT_L(0); PG8_BAR; PG8_MMA(0, 0, At, B0); PG8_MMA(0, 1, At, B1); PG8_BAR; PG8_SCHED;
            PG8_LDA(At, 1, 1); PG8_STAGE(PG8_SB(1, 0), b3, voffB); PG8_STAGE(PG8_SB(1, 1), b3 + hstep, voffB); PG8_STAGE(PG8_SA(1, 0), a3, voffA);
            PG8_WAIT_V(8); PG8_WAIT_L(0); PG8_BAR; PG8_MMA(1, 0, At, B0); PG8_MMA(1, 1, At, B1); PG8_BAR; PG8_SCHED;
            } else {
            PG8_LDB(B0, 0, 0); PG8_SCHED; PG8_LDA(At, 0, 0); PG8_STAGE(PG8_SA(1, 1), a1 + hstep, voffA);
            PG8_WAIT_L(8); PG8_BAR; PG8_WAIT_L(0); PG8_MMA(0, 0, At, B0); PG8_BAR; PG8_SCHED;
            PG8_LDB(B1, 0, 1); PG8_STAGE(PG8_SB(0, 0), b2, voffB);
            PG8_BAR; PG8_WAIT_L(0); PG8_MMA(0, 1, At, B1); PG8_BAR;
            PG8_LDA(At, 0, 1); PG8_STAGE(PG8_SA(0, 0), a2, voffA);
            PG8_BAR; PG8_WAIT_L(0); PG8_MMA(1, 0, At, B0); PG8_BAR; PG8_SCHED;
            PG8_STAGE(PG8_SB(0, 1), b2 + hstep, voffB);
            PG8_WAIT_V(6); PG8_BAR; PG8_MMA(1, 1, At, B1); PG8_BAR;
            PG8_LDB(B0, 1, 0); PG8_SCHED; PG8_LDA(At, 1, 0); PG8_STAGE(PG8_SA(0, 1), a2 + hstep, voffA);
            PG8_WAIT_L(8); PG8_BAR; PG8_WAIT_L(0); PG8_MMA(0, 0, At, B0); PG8_BAR; PG8_SCHED;
            PG8_LDB(B1, 1, 1); PG8_STAGE(PG8_SB(1, 0), b3, voffB);
            PG8_BAR; PG8_WAIT_L(0); PG8_MMA(0, 1, At, B1); PG8_BAR;
            PG8_LDA(At, 1, 1); PG8_STAGE(PG8_SA(1, 0), a3, voffA);
            PG8_BAR; PG8_WAIT_L(0); PG8_MMA(1, 0, At, B0); PG8_BAR; PG8_SCHED;
            PG8_STAGE(PG8_SB(1, 1), b3 + hstep, voffB);
            PG8_WAIT_V(6); PG8_BAR; PG8_MMA(1, 1, At, B1); PG8_BAR;
            }
        }
        if constexpr (ALIGN_EPI) { if (wr == 0) PG8_BAR; }
        if constexpr (!Epi::AFTER_DRAIN) { E(acc, cur, wr, wc, fr, fq); S.done(cur); if (has_next) S.after_epi(nxt); }
        if (!has_next) break;
#pragma unroll
        for (int a = 0; a < 2; ++a)
#pragma unroll
            for (int b = 0; b < 2; ++b)
#pragma unroll
                for (int m = 0; m < 4; ++m)
#pragma unroll
                    for (int n = 0; n < 2; ++n) acc[a][b][m][n] = (f32x4){0.f, 0.f, 0.f, 0.f};
        cur = nxt; cA = nA; cB = nB; ++ui;
        if constexpr (ALIGN_EPI) { if (wr == 1) PG8_BAR; }
    }
    PG8_WAIT_V(0);
    if constexpr (!ALIGN_EPI) { if (wr == 0) PG8_BAR; }
    PG8_BAR;
    if constexpr (Epi::AFTER_DRAIN) { E.fused(acc, cur, wr, wc, fr, fq, lds, wid, lane); S.done(cur); }
#undef PG8_SA
#undef PG8_SB
#undef PG8_STAGE
#undef PG8_LDA
#undef PG8_LDB
#undef PG8_MMA
#undef PG8_WAIT_V
#undef PG8_WAIT_L
#undef PG8_BAR
#undef PG8_SCHED
}
}

#define LAS __attribute__((address_space(3)))
#define GAS __attribute__((address_space(1)))
typedef unsigned short bf16;
typedef float f32x4 __attribute__((ext_vector_type(4)));
typedef float f32x2 __attribute__((ext_vector_type(2)));
typedef short bf16x8 __attribute__((ext_vector_type(8)));
typedef unsigned u32x4 __attribute__((ext_vector_type(4)));
typedef unsigned u32x2 __attribute__((ext_vector_type(2)));
using pg8::cvt_pk_bf16;
using pg8::Unit;

constexpr int NB_ = 8, SEQ = 4096, D = 1024, M = NB_ * SEQ;
constexpr int DT = 768, DM = 256, NA = 4 * DT + DM, NBW = 2 * DT + DM, FF = 2816, NF = 2 * FF, ML = 256, MM = NB_ * ML;
constexpr float EPS = 1e-6f;
constexpr float QSCALE = 0.125f * 1.44269504089f;
constexpr int LDS_BYTES = 147456;

constexpr size_t MiB = 1u << 20;
constexpr size_t WS_WINA = 0, WS_WINB = 7 * MiB, WS_WOUT = 11 * MiB, WS_WFFI = 15 * MiB, WS_WFFO = 37 * MiB, WS_WKV = 48 * MiB, WS_WSB = 50 * MiB,
                 WS_MISC = 51 * MiB, WS_PART = 52 * MiB, WS_LNP = 54 * MiB, WS_MPART = 57 * MiB, WS_MEMB = 58 * MiB, WS_KV = 62 * MiB, WS_XB = 66 * MiB,
                 WS_HEADS = 130 * MiB, WS_QM = 194 * MiB, WS_R = 210 * MiB, WS_Q = WS_R, WS_V = WS_R + 48 * MiB, WS_G = WS_R + 96 * MiB, WS_LF = WS_R + 144 * MiB,
                 WS_ACT = WS_R, WS_END = 450 * MiB, WS_BAR = WS_MISC + 65536;

__device__ __forceinline__ float bf2f(unsigned short b) { return __uint_as_float(((unsigned)b) << 16); }
__device__ __forceinline__ float bflo(unsigned w) { return __uint_as_float(w << 16); }
__device__ __forceinline__ float bfhi(unsigned w) { return __uint_as_float(w & 0xffff0000u); }
__device__ __forceinline__ unsigned short f2bf(float f) { return (unsigned short)(cvt_pk_bf16(f, 0.f) & 0xffffu); }
__device__ __forceinline__ float wave_sum(float v) {
#pragma unroll
    for (int o = 1; o < 64; o <<= 1) v += __shfl_xor(v, o);
    return v;
}
__device__ __forceinline__ float sum16(const float* p) {
    const f32x4 a = ((const f32x4*)p)[0], b = ((const f32x4*)p)[1], c = ((const f32x4*)p)[2], d = ((const f32x4*)p)[3];
    return (((a.x + a.y) + (a.z + a.w)) + ((b.x + b.y) + (b.z + b.w))) + (((c.x + c.y) + (c.z + c.w)) + ((d.x + d.y) + (d.z + d.w)));
}
__device__ __forceinline__ float row_rstd(const float* ss, int row) { return rsqrtf(ss[row] * (1.0f / 1024.0f) + EPS); }
__device__ __forceinline__ float lds_rstd(const LAS float* rs, int r) { return __builtin_amdgcn_rsqf(rs[r] * (1.0f / 1024.0f) + EPS); }
__device__ __forceinline__ f32x4 sigmoid4(f32x4 x) { const f32x4 t = x * -1.44269504089f; f32x4 e; e[0] = __builtin_amdgcn_exp2f(t[0]); e[1] = __builtin_amdgcn_exp2f(t[1]); e[2] = __builtin_amdgcn_exp2f(t[2]); e[3] = __builtin_amdgcn_exp2f(t[3]);
    e = e + 1.0f; f32x4 r; r[0] = __builtin_amdgcn_rcpf(e[0]); r[1] = __builtin_amdgcn_rcpf(e[1]); r[2] = __builtin_amdgcn_rcpf(e[2]); r[3] = __builtin_amdgcn_rcpf(e[3]); return r; }
__device__ __forceinline__ float sigmoidf_(float x) { return __builtin_amdgcn_rcpf(1.0f + __builtin_amdgcn_exp2f(x * -1.44269504089f)); }

struct RsOrder : pg8::StaticOrder { const GAS float* ss; mutable float pa, pb; mutable int nth;
    __device__ __forceinline__ void after_epi(const Unit& u) const { if (nth > 0) { const int t = threadIdx.x, r = u.pm * 256 + ((t >> 8) & 1) * 64 + (t & 63); pa = ss[r]; pb = ss[r + 128]; } ++nth; } };
__device__ __forceinline__ float shfl_rstd(const RsOrder* sc, bool first, int row, int ai, int m, int fr) {
    float s; if (first) s = sc->ss[row]; else s = __shfl(ai ? sc->pb : sc->pa, m * 16 + fr);
    return __builtin_amdgcn_rsqf(s * (1.0f / 1024.0f) + EPS); }
struct EpiProjA {
    static constexpr bool PERM = true, AFTER_DRAIN = false;
    const RsOrder* sc; LAS float* rs; GAS bf16* Q; GAS float* LF; GAS bf16* V; GAS bf16* G; GAS bf16* QM; const GAS float* lb; const GAS float* onorm;
    __device__ __forceinline__ void operator()(const f32x4 (&acc)[2][2][4][2], const Unit& u, int wr, int wc, int fr, int fq) const {
        const bool first = true;
        const int row0 = u.pm * 256 + wr * 64 + fr;
        const int type = u.pn / 3, col0 = (u.pn - type * 3) * 256 + wc * 32 + 8 * fq;
        f32x4 aux[2][2];
#pragma unroll
        for (int bj = 0; bj < 2; ++bj)
#pragma unroll
            for (int n = 0; n < 2; ++n) { aux[bj][n] = (f32x4){0.f, 0.f, 0.f, 0.f};
                if (type == 1) aux[bj][n] = *(const GAS f32x4*)(lb + col0 + bj * 128 + 4 * n);
                if (type == 3) aux[bj][n] = *(const GAS f32x4*)(onorm + col0 + bj * 128 + 4 * n); }
#pragma unroll
        for (int ai = 0; ai < 2; ++ai)
#pragma unroll
            for (int m = 0; m < 4; ++m) {
                const int row = row0 + ai * 128 + m * 16; const float rs = shfl_rstd(sc, first, row, ai, m, fr);
#pragma unroll
                for (int bj = 0; bj < 2; ++bj) {
                    f32x4 v0 = acc[ai][bj][m][0] * rs, v1 = acc[ai][bj][m][1] * rs; const int col = col0 + bj * 128;
                    if (type == 1) {
                        const f32x4 s0 = sigmoid4(v0), s1 = sigmoid4(v1), l0 = aux[bj][0], l1 = aux[bj][1];
                        const f32x4 f0 = l0 + (1.0f - l0) * s0, f1 = l1 + (1.0f - l1) * s1; f32x4 o0, o1;
#pragma unroll
                        for (int j = 0; j < 4; ++j) { o0[j] = __builtin_amdgcn_logf(f0[j]); o1[j] = __builtin_amdgcn_logf(f1[j]); }
                        o0 = o0 * 0.69314718056f; o1 = o1 * 0.69314718056f;
                        GAS float* p = LF + (size_t)row * DT + col; *(GAS f32x4*)p = o0; *(GAS f32x4*)(p + 4) = o1;
                    } else {
                        GAS bf16* dst;
                        if (type == 0) dst = Q + (size_t)row * DT + col;
                        else if (type == 2) dst = V + (size_t)row * DT + col;
                        else if (type == 3) { dst = G + (size_t)row * DT + col;
                            v0 = v0 * sigmoid4(v0) * aux[bj][0]; v1 = v1 * sigmoid4(v1) * aux[bj][1]; }
                        else { dst = QM + (size_t)row * DM + col; v0 = v0 * QSCALE; v1 = v1 * QSCALE; }
                        u32x4 w; w.x = cvt_pk_bf16(v0[0], v0[1]); w.y = cvt_pk_bf16(v0[2], v0[3]); w.z = cvt_pk_bf16(v1[0], v1[1]); w.w = cvt_pk_bf16(v1[2], v1[3]);
                        *(GAS u32x4*)dst = w;
                    }
                }
            }
    }
};
struct EpiProjB {
    static constexpr bool PERM = true, AFTER_DRAIN = false;
    const RsOrder* sc; LAS float* rs; GAS bf16* U; GAS bf16* VG; GAS bf16* QM; GAS float* lnp;
    __device__ __forceinline__ void operator()(const f32x4 (&acc)[2][2][4][2], const Unit& u, int wr, int wc, int fr, int fq) const {
        const bool first = true;
        const int row0 = u.pm * 256 + wr * 64 + fr;
        const int type = u.pn / 3, col0 = (u.pn - type * 3) * 256 + wc * 32 + 8 * fq;
#pragma unroll
        for (int ai = 0; ai < 2; ++ai)
#pragma unroll
            for (int m = 0; m < 4; ++m) {
                const int row = row0 + ai * 128 + m * 16; const float rs = shfl_rstd(sc, first, row, ai, m, fr);
                float s1[2] = {0.f, 0.f}, s2[2] = {0.f, 0.f};
#pragma unroll
                for (int bj = 0; bj < 2; ++bj) {
                    f32x4 v0 = acc[ai][bj][m][0] * rs, v1 = acc[ai][bj][m][1] * rs; const int col = col0 + bj * 128;
                    GAS bf16* dst;
                    if (type == 2) { dst = QM + (size_t)row * DM + col; v0 = v0 * QSCALE; v1 = v1 * QSCALE; }
                    else {
                        const f32x2 a = pg8::gelu_pk((f32x2){v0[0], v0[1]}), b = pg8::gelu_pk((f32x2){v0[2], v0[3]}), c = pg8::gelu_pk((f32x2){v1[0], v1[1]}), d = pg8::gelu_pk((f32x2){v1[2], v1[3]});
                        v0 = (f32x4){a.x, a.y, b.x, b.y}; v1 = (f32x4){c.x, c.y, d.x, d.y};
                        dst = (type == 0 ? U : VG) + (size_t)row * DT + col;
                        s1[bj] = ((v0[0] + v0[1]) + (v0[2] + v0[3])) + ((v1[0] + v1[1]) + (v1[2] + v1[3]));
                        s2[bj] = ((v0[0] * v0[0] + v0[1] * v0[1]) + (v0[2] * v0[2] + v0[3] * v0[3])) + ((v1[0] * v1[0] + v1[1] * v1[1]) + (v1[2] * v1[2] + v1[3] * v1[3]));
                    }
                    u32x4 w; w.x = cvt_pk_bf16(v0[0], v0[1]); w.y = cvt_pk_bf16(v0[2], v0[3]); w.z = cvt_pk_bf16(v1[0], v1[1]); w.w = cvt_pk_bf16(v1[2], v1[3]);
                    *(GAS u32x4*)dst = w;
                }
                if (type == 1) {
                    float a = s1[0] + s1[1], b = s2[0] + s2[1]; a += __shfl_xor(a, 16); a += __shfl_xor(a, 32); b += __shfl_xor(b, 16); b += __shfl_xor(b, 32);
                    if (fq == 0) { GAS float* p = lnp + (size_t)row * 24 + ((u.pn - 3) * 4 + wc) * 2; *(GAS f32x2*)p = (f32x2){a, b}; }
                }
            }
    }
};
struct EpiKV {
    static constexpr bool PERM = true, AFTER_DRAIN = false;
    const RsOrder* sc; LAS float* rs; GAS bf16* O;
    __device__ __forceinline__ void operator()(const f32x4 (&acc)[2][2][4][2], const Unit& u, int wr, int wc, int fr, int fq) const {
        const bool first = true;
        const int row0 = u.pm * 256 + wr * 64 + fr, col0 = u.pn * 256 + wc * 32 + 8 * fq;
#pragma unroll
        for (int ai = 0; ai < 2; ++ai)
#pragma unroll
            for (int m = 0; m < 4; ++m) {
                const int row = row0 + ai * 128 + m * 16; const float rs = shfl_rstd(sc, first, row, ai, m, fr);
#pragma unroll
                for (int bj = 0; bj < 2; ++bj) { const f32x4 v0 = acc[ai][bj][m][0] * rs, v1 = acc[ai][bj][m][1] * rs;
                    u32x4 w; w.x = cvt_pk_bf16(v0[0], v0[1]); w.y = cvt_pk_bf16(v0[2], v0[3]); w.z = cvt_pk_bf16(v1[0], v1[1]); w.w = cvt_pk_bf16(v1[2], v1[3]);
                    *(GAS u32x4*)(O + (size_t)row * 1024 + col0 + bj * 128) = w; }
            }
    }
};
struct EpiRes {
    static constexpr bool PERM = true, AFTER_DRAIN = false;
    const GAS float* base32; GAS float* out32; GAS bf16* xb; GAS float* part;
    __device__ __forceinline__ void operator()(const f32x4 (&acc)[2][2][4][2], const Unit& u, int wr, int wc, int fr, int fq) const {
        const int row0 = u.pm * 256 + wr * 64 + fr, col0 = u.pn * 256 + wc * 32 + 8 * fq;
#pragma unroll
        for (int ai = 0; ai < 2; ++ai)
#pragma unroll
            for (int m = 0; m < 4; ++m) {
                const int row = row0 + ai * 128 + m * 16; f32x4 sv = (f32x4){0.f, 0.f, 0.f, 0.f};
#pragma unroll
                for (int bj = 0; bj < 2; ++bj) { const size_t off = (size_t)row * D + col0 + bj * 128;
                    f32x4 x0, x1;
                    if (base32) { x0 = *(const GAS f32x4*)(base32 + off); x1 = *(const GAS f32x4*)(base32 + off + 4); }
                    else { const u32x4 w = *(const GAS u32x4*)(xb + off); x0 = (f32x4){bflo(w.x), bfhi(w.x), bflo(w.y), bfhi(w.y)}; x1 = (f32x4){bflo(w.z), bfhi(w.z), bflo(w.w), bfhi(w.w)}; }
                    x0 = x0 + acc[ai][bj][m][0]; x1 = x1 + acc[ai][bj][m][1];
                    if (out32) { *(GAS f32x4*)(out32 + off) = x0; *(GAS f32x4*)(out32 + off + 4) = x1; }
                    else { u32x4 w; w.x = cvt_pk_bf16(x0[0], x0[1]); w.y = cvt_pk_bf16(x0[2], x0[3]); w.z = cvt_pk_bf16(x1[0], x1[1]); w.w = cvt_pk_bf16(x1[2], x1[3]); *(GAS u32x4*)(xb + off) = w; }
                    sv = sv + x0 * x0; sv = sv + x1 * x1; }
                float ss = (sv[0] + sv[1]) + (sv[2] + sv[3]);
                ss += __shfl_xor(ss, 16); ss += __shfl_xor(ss, 32);
                if (fq == 0) __hip_atomic_fetch_add((GAS float*)(part + row), ss, __ATOMIC_RELAXED, __HIP_MEMORY_SCOPE_AGENT);
            }
    }
};
struct EpiFfn {
    static constexpr bool PERM = true, AFTER_DRAIN = false;
    const RsOrder* sc; LAS float* rs; GAS bf16* ACT;
    __device__ __forceinline__ void operator()(const f32x4 (&acc)[2][2][4][2], const Unit& u, int wr, int wc, int fr, int fq) const {
        const bool first = true;
        const int row0 = u.pm * 256 + wr * 64 + fr, col0 = u.pn * 128 + wc * 32 + 8 * fq;
#pragma unroll
        for (int ai = 0; ai < 2; ++ai)
#pragma unroll
            for (int m = 0; m < 4; ++m) {
                const int row = row0 + ai * 128 + m * 16; const float rs = shfl_rstd(sc, first, row, ai, m, fr), rs2 = rs * -1.44269504089f, rsq = rs * rs;
                f32x4 o[2];
#pragma unroll
                for (int n = 0; n < 2; ++n) {
                    const f32x4 g = acc[ai][0][m][n], up = acc[ai][1][m][n]; const f32x4 t = g * rs2; f32x4 e;
                    e[0] = __builtin_amdgcn_exp2f(t[0]); e[1] = __builtin_amdgcn_exp2f(t[1]); e[2] = __builtin_amdgcn_exp2f(t[2]); e[3] = __builtin_amdgcn_exp2f(t[3]);
                    e = e + 1.0f; f32x4 r; r[0] = __builtin_amdgcn_rcpf(e[0]); r[1] = __builtin_amdgcn_rcpf(e[1]); r[2] = __builtin_amdgcn_rcpf(e[2]); r[3] = __builtin_amdgcn_rcpf(e[3]);
                    o[n] = (g * up) * (r * rsq); }
                u32x4 w; w.x = cvt_pk_bf16(o[0][0], o[0][1]); w.y = cvt_pk_bf16(o[0][2], o[0][3]); w.z = cvt_pk_bf16(o[1][0], o[1][1]); w.w = cvt_pk_bf16(o[1][2], o[1][3]);
                *(GAS u32x4*)(ACT + (size_t)row * FF + col0) = w;
            }
    }
};

__device__ __forceinline__ void transpose_item(const float* W, int K, int N, const float* gain, bf16* WT, int k0, int n0, int orow0, LAS float* scr, int lane) {
    float tv[32];
#pragma unroll
    for (int i = 0; i < 32; ++i) tv[i] = W[(size_t)(k0 + 2 * i + (lane >> 5)) * N + n0 + (lane & 31)];
    if (gain) {
#pragma unroll
        for (int i = 0; i < 32; ++i) tv[i] *= gain[k0 + 2 * i + (lane >> 5)]; }
#pragma unroll
    for (int i = 0; i < 32; ++i) scr[(2 * i + (lane >> 5)) * 33 + (lane & 31)] = tv[i];
    asm volatile("s_waitcnt lgkmcnt(0)" ::: "memory");
    const int c = lane & 7;
#pragma unroll
    for (int j = 0; j < 4; ++j) { const int n = (lane >> 3) + 8 * j; const LAS float* s = scr + (8 * c) * 33 + n;
        u32x4 o; o.x = cvt_pk_bf16(s[0 * 33], s[1 * 33]); o.y = cvt_pk_bf16(s[2 * 33], s[3 * 33]); o.z = cvt_pk_bf16(s[4 * 33], s[5 * 33]); o.w = cvt_pk_bf16(s[6 * 33], s[7 * 33]);
        *(u32x4*)(WT + (size_t)(orow0 + n) * K + k0 + 8 * c) = o; }
    asm volatile("s_waitcnt lgkmcnt(0)" ::: "memory");
}
template <int NR> __device__ __forceinline__ void rows_to_bf16(const float* xrow, bf16* orow, float* part, int lane) {
    f32x4 v[NR][4];
#pragma unroll
    for (int r = 0; r < NR; ++r)
#pragma unroll
        for (int j = 0; j < 4; ++j) v[r][j] = __builtin_nontemporal_load((const f32x4*)(xrow + (size_t)r * D) + lane + 64 * j);
#pragma unroll
    for (int r = 0; r < NR; ++r) { float s = 0.f;
#pragma unroll
        for (int j = 0; j < 4; ++j) s += (v[r][j].x * v[r][j].x + v[r][j].y * v[r][j].y) + (v[r][j].z * v[r][j].z + v[r][j].w * v[r][j].w);
        s = wave_sum(s);
        u32x2* o8 = (u32x2*)(orow + (size_t)r * D) + lane;
#pragma unroll
        for (int j = 0; j < 4; ++j) { u32x2 w; w.x = cvt_pk_bf16(v[r][j].x, v[r][j].y); w.y = cvt_pk_bf16(v[r][j].z, v[r][j].w); o8[64 * j] = w; }
        if (lane == 0) part[r] = s; }
}

__device__ __forceinline__ void convert_matrix(const float* W, int K, int N, const float* gain, bf16* WT, bool ffn_perm, int rowoff, int gw, int NGW, LAS float* scr, int lane) {
    const int nb = N / 32, nit = (K / 64) * nb;
    for (int r = gw; r < nit; r += NGW) { const int k0 = (r / nb) * 64, n0 = (r % nb) * 32; int orow0 = rowoff + n0;
        if (ffn_perm) { const int up = n0 >= FF ? 1 : 0, nn = n0 - up * FF; orow0 = 256 * (nn / 128) + 128 * up + (nn % 128); }
        transpose_item(W, K, N, gain, WT, k0, n0, orow0, scr, lane); }
}
struct Args { const float* in[18]; float* out; unsigned char* ws; };
__device__ __forceinline__ void convert_group(const Args& a, unsigned char* ws, int grp, int gw, int NGW, LAS float* scr, int lane) {
    if (grp == 1) convert_matrix(a.in[9], D, NBW, a.in[2] + D, (bf16*)(ws + WS_WINB), false, 0, gw, NGW, scr, lane);
    const int l = grp - 1;
    convert_matrix(a.in[5] + (size_t)l * D * D, D, D, nullptr, (bf16*)(ws + WS_WOUT) + (size_t)l * D * D, false, 0, gw, NGW, scr, lane);
    convert_matrix(a.in[15] + (size_t)l * D * NF, D, NF, a.in[14] + l * D, (bf16*)(ws + WS_WFFI) + (size_t)l * NF * D, true, 0, gw, NGW, scr, lane);
    convert_matrix(a.in[16] + (size_t)l * FF * D, FF, D, nullptr, (bf16*)(ws + WS_WFFO) + (size_t)l * D * FF, false, 0, gw, NGW, scr, lane);
}
struct ReverseOrder : pg8::StaticOrder { int R; __device__ void initr(int M_, int N_, int G_, int c_) { init(M_, N_, G_, c_); R = (nwg + G_ - 1) / G_; }
    __device__ bool next(int i, Unit& u) const { return i < R && pg8::StaticOrder::next(R - 1 - i, u); } };

__device__ __forceinline__ void memattn_unit(LAS unsigned char* lds, const bf16* QM, const bf16* KV, bf16* HEADS, int layer, int tile, int h, int tid) {
    LAS bf16* Ks = (LAS bf16*)lds;
    LAS bf16* Vt = (LAS bf16*)(lds + 36864);
    const int lane = tid & 63, wave = tid >> 6, fr = lane & 15, fq = lane >> 4;
    const int b = tile >> 4;
    { const int key = tid >> 1, half = tid & 1;
      const bf16* kp = KV + (size_t)(b * ML + key) * 1024 + layer * 512 + h * 64 + half * 32; const bf16* vp = kp + 256;
#pragma unroll
      for (int i = 0; i < 4; ++i) *(LAS u32x4*)(Ks + key * 72 + half * 32 + i * 8) = *(const u32x4*)(kp + i * 8);
#pragma unroll
      for (int i = 0; i < 4; ++i) { const u32x4 w = *(const u32x4*)(vp + i * 8); const unsigned ww[4] = {w.x, w.y, w.z, w.w};
#pragma unroll
          for (int j = 0; j < 4; ++j) { const int d = half * 32 + i * 8 + j * 2; Vt[d * 264 + key] = (bf16)(ww[j] & 0xffffu); Vt[(d + 1) * 264 + key] = (bf16)(ww[j] >> 16); } } }
    __syncthreads();
    for (int qt = 0; qt < 2; ++qt) {
        const int q = tile * 256 + wave * 32 + qt * 16 + fr;
        bf16x8 qf[2];
#pragma unroll
        for (int ks = 0; ks < 2; ++ks) qf[ks] = *(const bf16x8*)(QM + (size_t)q * DM + h * 64 + ks * 32 + 8 * fq);
        f32x4 s[16];
#pragma unroll
        for (int kt = 0; kt < 16; ++kt) { s[kt] = (f32x4){0.f, 0.f, 0.f, 0.f};
#pragma unroll
            for (int ks = 0; ks < 2; ++ks) { const bf16x8 a = *(const LAS bf16x8*)(Ks + (kt * 16 + fr) * 72 + ks * 32 + 8 * fq); s[kt] = __builtin_amdgcn_mfma_f32_16x16x32_bf16(a, qf[ks], s[kt], 0, 0, 0); } }
        float mx = -3.0e38f;
#pragma unroll
        for (int kt = 0; kt < 16; ++kt) mx = fmaxf(fmaxf(fmaxf(s[kt][0], s[kt][1]), fmaxf(s[kt][2], s[kt][3])), mx);
        mx = fmaxf(mx, __shfl_xor(mx, 16)); mx = fmaxf(mx, __shfl_xor(mx, 32));
        float sum = 0.f;
#pragma unroll
        for (int kt = 0; kt < 16; ++kt) {
#pragma unroll
            for (int j = 0; j < 4; ++j) { s[kt][j] = __builtin_amdgcn_exp2f(s[kt][j] - mx); sum += s[kt][j]; } }
        sum += __shfl_xor(sum, 16); sum += __shfl_xor(sum, 32);
        const float inv = 1.0f / sum;
        f32x4 o[4];
#pragma unroll
        for (int dt = 0; dt < 4; ++dt) o[dt] = (f32x4){0.f, 0.f, 0.f, 0.f};
#pragma unroll
        for (int k2 = 0; k2 < 8; ++k2) {
            u32x4 pw; pw.x = cvt_pk_bf16(s[2 * k2][0], s[2 * k2][1]); pw.y = cvt_pk_bf16(s[2 * k2][2], s[2 * k2][3]); pw.z = cvt_pk_bf16(s[2 * k2 + 1][0], s[2 * k2 + 1][1]); pw.w = cvt_pk_bf16(s[2 * k2 + 1][2], s[2 * k2 + 1][3]);
            const bf16x8 pb = __builtin_bit_cast(bf16x8, pw);
#pragma unroll
            for (int dt = 0; dt < 4; ++dt) {
                const u32x2 e0 = *(const LAS u32x2*)(Vt + (dt * 16 + fr) * 264 + (2 * k2) * 16 + 4 * fq), e1 = *(const LAS u32x2*)(Vt + (dt * 16 + fr) * 264 + (2 * k2 + 1) * 16 + 4 * fq);
                u32x4 aw; aw.x = e0.x; aw.y = e0.y; aw.z = e1.x; aw.w = e1.y;
                o[dt] = __builtin_amdgcn_mfma_f32_16x16x32_bf16(__builtin_bit_cast(bf16x8, aw), pb, o[dt], 0, 0, 0); }
        }
#pragma unroll
        for (int dt = 0; dt < 4; ++dt) { u32x2 w; w.x = cvt_pk_bf16(o[dt][0] * inv, o[dt][1] * inv); w.y = cvt_pk_bf16(o[dt][2] * inv, o[dt][3] * inv);
            *(u32x2*)(HEADS + (size_t)q * D + DT + h * 64 + dt * 16 + 4 * fq) = w; }
    }
    __syncthreads();
}
__device__ __forceinline__ void memattn_block(LAS unsigned char* lds, const GAS bf16* QM, const GAS bf16* KV, GAS bf16* HEADS, int layer, int first, int stride, int limit, int tid) {
    LAS bf16* Ks = (LAS bf16*)lds;
    LAS bf16* Vt = (LAS bf16*)(lds + 36864);
    const int lane = tid & 63, wave = tid >> 6, fr = lane & 15, fq = lane >> 4;
    const int key = tid >> 1, half = tid & 1;
    if (first >= limit) return;
    u32x4 kr[4], vr[4];
#define MA_LOAD(u_) do { const int b_ = ((u_) >> 2) >> 4; const GAS bf16* kp_ = KV + (size_t)(b_ * ML + key) * 1024 + layer * 512 + ((u_) & 3) * 64 + half * 32; \
        _Pragma("unroll") for (int i = 0; i < 4; ++i) { kr[i] = *(const GAS u32x4*)(kp_ + i * 8); vr[i] = *(const GAS u32x4*)(kp_ + 256 + i * 8); } } while (0)
    int unit = first;
    MA_LOAD(unit);
    for (;;) {
        const int tile = unit >> 2, h = unit & 3;
#pragma unroll
        for (int i = 0; i < 4; ++i) *(LAS u32x4*)(Ks + key * 72 + half * 32 + i * 8) = kr[i];
#pragma unroll
        for (int i = 0; i < 4; ++i) { const unsigned ww[4] = {vr[i].x, vr[i].y, vr[i].z, vr[i].w};
#pragma unroll
            for (int j = 0; j < 4; ++j) { const int d = half * 32 + i * 8 + j * 2; Vt[d * 264 + key] = (bf16)(ww[j] & 0xffffu); Vt[(d + 1) * 264 + key] = (bf16)(ww[j] >> 16); } }
        __syncthreads();
        bf16x8 qall[2][2];
#pragma unroll
        for (int qt = 0; qt < 2; ++qt)
#pragma unroll
            for (int ks = 0; ks < 2; ++ks) qall[qt][ks] = *(const GAS bf16x8*)(QM + (size_t)(tile * 256 + wave * 32 + qt * 16 + fr) * DM + h * 64 + ks * 32 + 8 * fq);
        const int next = unit + stride; const bool has_next = next < limit;
        if (has_next) MA_LOAD(next);
    for (int qt = 0; qt < 2; ++qt) {
        const int q = tile * 256 + wave * 32 + qt * 16 + fr;
        bf16x8 qf[2];
#pragma unroll
        for (int ks = 0; ks < 2; ++ks) qf[ks] = qall[qt][ks];
        f32x4 s[16];
#pragma unroll
        for (int kt = 0; kt < 16; ++kt) { s[kt] = (f32x4){0.f, 0.f, 0.f, 0.f};
#pragma unroll
            for (int ks = 0; ks < 2; ++ks) { const bf16x8 a = *(const LAS bf16x8*)(Ks + (kt * 16 + fr) * 72 + ks * 32 + 8 * fq); s[kt] = __builtin_amdgcn_mfma_f32_16x16x32_bf16(a, qf[ks], s[kt], 0, 0, 0); } }
        float mx = -3.0e38f;
#pragma unroll
        for (int kt = 0; kt < 16; ++kt) mx = fmaxf(fmaxf(fmaxf(s[kt][0], s[kt][1]), fmaxf(s[kt][2], s[kt][3])), mx);
        mx = fmaxf(mx, __shfl_xor(mx, 16)); mx = fmaxf(mx, __shfl_xor(mx, 32));
        float sum = 0.f;
#pragma unroll
        for (int kt = 0; kt < 16; ++kt) {
#pragma unroll
            for (int j = 0; j < 4; ++j) { s[kt][j] = __builtin_amdgcn_exp2f(s[kt][j] - mx); sum += s[kt][j]; } }
        sum += __shfl_xor(sum, 16); sum += __shfl_xor(sum, 32);
        const float inv = 1.0f / sum;
        f32x4 o[4];
#pragma unroll
        for (int dt = 0; dt < 4; ++dt) o[dt] = (f32x4){0.f, 0.f, 0.f, 0.f};
#pragma unroll
        for (int k2 = 0; k2 < 8; ++k2) {
            u32x4 pw; pw.x = cvt_pk_bf16(s[2 * k2][0], s[2 * k2][1]); pw.y = cvt_pk_bf16(s[2 * k2][2], s[2 * k2][3]); pw.z = cvt_pk_bf16(s[2 * k2 + 1][0], s[2 * k2 + 1][1]); pw.w = cvt_pk_bf16(s[2 * k2 + 1][2], s[2 * k2 + 1][3]);
            const bf16x8 pb = __builtin_bit_cast(bf16x8, pw);
#pragma unroll
            for (int dt = 0; dt < 4; ++dt) {
                const u32x2 e0 = *(const LAS u32x2*)(Vt + (dt * 16 + fr) * 264 + (2 * k2) * 16 + 4 * fq), e1 = *(const LAS u32x2*)(Vt + (dt * 16 + fr) * 264 + (2 * k2 + 1) * 16 + 4 * fq);
                u32x4 aw; aw.x = e0.x; aw.y = e0.y; aw.z = e1.x; aw.w = e1.y;
                o[dt] = __builtin_amdgcn_mfma_f32_16x16x32_bf16(__builtin_bit_cast(bf16x8, aw), pb, o[dt], 0, 0, 0); }
        }
#pragma unroll
        for (int dt = 0; dt < 4; ++dt) { u32x2 w; w.x = cvt_pk_bf16(o[dt][0] * inv, o[dt][1] * inv); w.y = cvt_pk_bf16(o[dt][2] * inv, o[dt][3] * inv);
            *(GAS u32x2*)(HEADS + (size_t)q * D + DT + h * 64 + dt * 16 + 4 * fq) = w; }
    }
        __syncthreads();
        if (!has_next) break;
        unit = next;
    }
#undef MA_LOAD
}

__device__ __forceinline__ void gmlp_unit(LAS unsigned char* lds, const bf16* U, const bf16* VG, const float* lnp, const float* ln_g, const float* ln_b, const bf16* WSB, const float* bsv,
                                          bf16* HEADS, int unit, int tid) {
    LAS bf16* VnT = (LAS bf16*)lds;
    const int lane = tid & 63, wave = tid >> 6, fr = lane & 15, fq = lane >> 4;
    const int g = unit % 6, bn = unit / 6; const int row0 = bn * 128;
    { const int s = tid & 127, cq = tid >> 7; const int row = row0 + s;
      float s1 = 0.f, s2 = 0.f; const f32x4* lp = (const f32x4*)(lnp + (size_t)row * 24);
#pragma unroll
      for (int i = 0; i < 6; ++i) { const f32x4 t = lp[i]; s1 += t.x + t.z; s2 += t.y + t.w; }
      const float mu = s1 * (1.0f / 768.0f), var = s2 * (1.0f / 768.0f) - mu * mu, rstd = rsqrtf(var + EPS);
      const bf16* vp = VG + (size_t)row * DT + g * 128 + cq * 32;
#pragma unroll
      for (int i = 0; i < 4; ++i) { const u32x4 w = *(const u32x4*)(vp + i * 8); const unsigned ww[4] = {w.x, w.y, w.z, w.w};
          const f32x4 g0 = *(const f32x4*)(ln_g + g * 128 + cq * 32 + i * 8), g1 = *(const f32x4*)(ln_g + g * 128 + cq * 32 + i * 8 + 4);
          const f32x4 b0 = *(const f32x4*)(ln_b + g * 128 + cq * 32 + i * 8), b1 = *(const f32x4*)(ln_b + g * 128 + cq * 32 + i * 8 + 4);
          const float gg[8] = {g0.x, g0.y, g0.z, g0.w, g1.x, g1.y, g1.z, g1.w}, bb[8] = {b0.x, b0.y, b0.z, b0.w, b1.x, b1.y, b1.z, b1.w};
#pragma unroll
          for (int j = 0; j < 4; ++j) { const int c = cq * 32 + i * 8 + j * 2;
              const float x0 = (bflo(ww[j]) - mu) * rstd * gg[2 * j] + bb[2 * j], x1 = (bfhi(ww[j]) - mu) * rstd * gg[2 * j + 1] + bb[2 * j + 1];
              const unsigned pk = cvt_pk_bf16(x0, x1); VnT[c * 136 + s] = (bf16)(pk & 0xffffu); VnT[(c + 1) * 136 + s] = (bf16)(pk >> 16); } } }
    __syncthreads();
    {
        const int t = wave * 16 + fr;
        bf16x8 wf[4];
#pragma unroll
        for (int ks = 0; ks < 4; ++ks) wf[ks] = *(const bf16x8*)(WSB + (size_t)g * 16384 + t * 128 + ks * 32 + 8 * fq);
        const float bias = bsv[g * 128 + t];
        const int row = row0 + t;
#pragma unroll
        for (int ct = 0; ct < 8; ++ct) {
            f32x4 acc = (f32x4){0.f, 0.f, 0.f, 0.f};
#pragma unroll
            for (int ks = 0; ks < 4; ++ks) { const bf16x8 a = *(const LAS bf16x8*)(VnT + (ct * 16 + fr) * 136 + ks * 32 + 8 * fq); acc = __builtin_amdgcn_mfma_f32_16x16x32_bf16(a, wf[ks], acc, 0, 0, 0); }
            const int col = g * 128 + ct * 16 + 4 * fq;
            const u32x2 uw = *(const u32x2*)(U + (size_t)row * DT + col);
            u32x2 w; w.x = cvt_pk_bf16(bflo(uw.x) * (acc[0] + bias), bfhi(uw.x) * (acc[1] + bias)); w.y = cvt_pk_bf16(bflo(uw.y) * (acc[2] + bias), bfhi(uw.y) * (acc[3] + bias));
            *(u32x2*)(HEADS + (size_t)row * D + col) = w;
        }
    }
    __syncthreads();
}

__device__ __forceinline__ void gmlp_block(LAS unsigned char* lds, const GAS bf16* U, const GAS bf16* VG, const GAS float* lnp, const GAS float* ln_g, const GAS float* ln_b, const GAS bf16* WSB,
                                           const GAS float* bsv, GAS bf16* HEADS, int first, int stride, int tid) {
    LAS bf16* VnT = (LAS bf16*)lds;
    const int lane = tid & 63, wave = __builtin_amdgcn_readfirstlane(tid >> 6), fr = lane & 15, fq = lane >> 4;
    const int s = tid & 127, cq = tid >> 7;
    if (first >= 1536) return;
    u32x4 vw[4]; f32x4 st[6];
#define GM_LOAD(unit_) do { const int g_ = (unit_) % 6, row_ = ((unit_) / 6) * 128 + s; const GAS f32x4* lp_ = (const GAS f32x4*)(lnp + (size_t)row_ * 24); \
        _Pragma("unroll") for (int i = 0; i < 6; ++i) st[i] = lp_[i]; \
        _Pragma("unroll") for (int i = 0; i < 4; ++i) vw[i] = *(const GAS u32x4*)(VG + (size_t)row_ * DT + g_ * 128 + cq * 32 + i * 8); } while (0)
    int unit = first;
    GM_LOAD(unit);
    for (;;) {
        const int g = unit % 6, row0 = (unit / 6) * 128;
        {
            float s1 = 0.f, s2 = 0.f;
#pragma unroll
            for (int i = 0; i < 6; ++i) { s1 += st[i].x + st[i].z; s2 += st[i].y + st[i].w; }
            const float mu = s1 * (1.0f / 768.0f), var = s2 * (1.0f / 768.0f) - mu * mu, rstd = __builtin_amdgcn_rsqf(var + EPS);
#pragma unroll
            for (int i = 0; i < 4; ++i) { const unsigned ww[4] = {vw[i].x, vw[i].y, vw[i].z, vw[i].w}; const int cb = g * 128 + cq * 32 + i * 8;
                const f32x4 g0 = *(const GAS f32x4*)(ln_g + cb), g1 = *(const GAS f32x4*)(ln_g + cb + 4), b0 = *(const GAS f32x4*)(ln_b + cb), b1 = *(const GAS f32x4*)(ln_b + cb + 4);
                const float gg[8] = {g0.x, g0.y, g0.z, g0.w, g1.x, g1.y, g1.z, g1.w}, bb[8] = {b0.x, b0.y, b0.z, b0.w, b1.x, b1.y, b1.z, b1.w};
#pragma unroll
                for (int j = 0; j < 4; ++j) { const int c = cq * 32 + i * 8 + j * 2;
                    const float x0 = (bflo(ww[j]) - mu) * rstd * gg[2 * j] + bb[2 * j], x1 = (bfhi(ww[j]) - mu) * rstd * gg[2 * j + 1] + bb[2 * j + 1];
                    const unsigned pk = cvt_pk_bf16(x0, x1); VnT[c * 136 + s] = (bf16)(pk & 0xffffu); VnT[(c + 1) * 136 + s] = (bf16)(pk >> 16); } }
        }
        __syncthreads();
        const int t = wave * 16 + fr, row = row0 + t;
        bf16x8 wf[4]; u32x2 uw[8];
#pragma unroll
        for (int ks = 0; ks < 4; ++ks) wf[ks] = *(const GAS bf16x8*)(WSB + (size_t)g * 16384 + t * 128 + ks * 32 + 8 * fq);
        const float bias = bsv[g * 128 + t];
#pragma unroll
        for (int ct = 0; ct < 8; ++ct) uw[ct] = *(const GAS u32x2*)(U + (size_t)row * DT + g * 128 + ct * 16 + 4 * fq);
        const int next = unit + stride; const bool has_next = next < 1536;
        if (has_next) GM_LOAD(next);
#pragma unroll
        for (int ct = 0; ct < 8; ++ct) {
            f32x4 acc = (f32x4){0.f, 0.f, 0.f, 0.f};
#pragma unroll
            for (int ks = 0; ks < 4; ++ks) { const bf16x8 a = *(const LAS bf16x8*)(VnT + (ct * 16 + fr) * 136 + ks * 32 + 8 * fq); acc = __builtin_amdgcn_mfma_f32_16x16x32_bf16(a, wf[ks], acc, 0, 0, 0); }
            u32x2 w; w.x = cvt_pk_bf16(bflo(uw[ct].x) * (acc[0] + bias), bfhi(uw[ct].x) * (acc[1] + bias)); w.y = cvt_pk_bf16(bflo(uw[ct].y) * (acc[2] + bias), bfhi(uw[ct].y) * (acc[3] + bias));
            *(GAS u32x2*)(HEADS + (size_t)row * D + g * 128 + ct * 16 + 4 * fq) = w;
        }
        __syncthreads();
        if (!has_next) break;
        unit = next;
    }
#undef GM_LOAD
}

__device__ __forceinline__ void hgrn_mfma_unit(LAS unsigned char* lds, const bf16* Q, bf16* Q2o, const float* LF, const bf16* V, bf16* HEADS, float* Ubuf, float* Dbuf, int unit, int tid) {
    constexpr int BUFB = 38400, OFF_KP = 8704, OFF_KH = 17408, OFF_VT = 27648, OFF_DD = 37888, OFF_O = 76800, OFF_TOT = 93696;
    const int lane = tid & 63, wave = __builtin_amdgcn_readfirstlane(tid >> 6), fr = lane & 15, fq = lane >> 4;
    const int seg = unit & 3, bh = unit >> 2, h = bh % 6, b = bh / 6, c0 = seg * 32;
    float run = 0.f;
    const int k = tid & 127, tq = tid >> 7;
    const int nt = tid >> 4, nsub = tid & 15;
    LAS float* OB = (LAS float*)(lds + OFF_O); LAS float* TOT = (LAS float*)(lds + OFF_TOT);
    f32x4 S[8];
#pragma unroll
    for (int i = 0; i < 8; ++i) S[i] = (f32x4){0.f, 0.f, 0.f, 0.f};
    float lfv[8], cs[8]; unsigned short qv[8], vv[8];
    const size_t colb = (size_t)h * 128 + k;
#define HG_LOAD(c) do { const size_t r0_ = (size_t)(b * SEQ + (c0 + (c)) * 32 + 8 * tq) * DT + colb; _Pragma("unroll") for (int j = 0; j < 8; ++j) { lfv[j] = LF[r0_ + (size_t)j * DT]; qv[j] = Q[r0_ + (size_t)j * DT]; vv[j] = V[r0_ + (size_t)j * DT]; } } while (0)
#define HG_PREP1() do { float c_ = 0.f; _Pragma("unroll") for (int j = 0; j < 8; ++j) { c_ += lfv[j]; cs[j] = c_; } TOT[tq * 128 + k] = c_; } while (0)
#define HG_PREP2(p, c) do { LAS unsigned char* B_ = lds + (p) * BUFB; const size_t r0_ = (size_t)(b * SEQ + (c0 + (c)) * 32 + 8 * tq) * DT + colb; LAS bf16* QT_ = (LAS bf16*)B_; LAS bf16* KP_ = (LAS bf16*)(B_ + OFF_KP); \
        const float t0_ = TOT[k], t1_ = TOT[128 + k], t2_ = TOT[256 + k], t3_ = TOT[384 + k]; \
        const float pre_ = tq == 0 ? 0.f : (tq == 1 ? t0_ : (tq == 2 ? t0_ + t1_ : (t0_ + t1_) + t2_)), bl_ = ((t0_ + t1_) + t2_) + t3_; \
        float kh_[8]; \
        _Pragma("unroll") for (int j = 0; j < 8; ++j) { const float bj_ = pre_ + cs[j], kk_ = 1.0f - __expf(lfv[j]); \
            const float qf_ = bf2f(qv[j]); QT_[(8 * tq + j) * 136 + k] = f2bf(qf_ * __expf(bj_)); Q2o[r0_ + (size_t)j * DT] = f2bf(qf_ * __expf(bj_ + run)); KP_[(8 * tq + j) * 136 + k] = f2bf(kk_ * __expf(fminf(-bj_, 70.0f))); kh_[j] = kk_ * __expf(bl_ - bj_); } \
        u32x4 w_; w_.x = cvt_pk_bf16(kh_[0], kh_[1]); w_.y = cvt_pk_bf16(kh_[2], kh_[3]); w_.z = cvt_pk_bf16(kh_[4], kh_[5]); w_.w = cvt_pk_bf16(kh_[6], kh_[7]); \
        *(LAS u32x4*)(B_ + OFF_KH + (k * 40 + 8 * tq) * 2) = w_; \
        u32x4 x_; x_.x = (unsigned)vv[0] | ((unsigned)vv[1] << 16); x_.y = (unsigned)vv[2] | ((unsigned)vv[3] << 16); x_.z = (unsigned)vv[4] | ((unsigned)vv[5] << 16); x_.w = (unsigned)vv[6] | ((unsigned)vv[7] << 16); \
        *(LAS u32x4*)(B_ + OFF_VT + (k * 40 + 8 * tq) * 2) = x_; \
        if (tq == 0) *(LAS float*)(B_ + OFF_DD + k * 4) = __expf(bl_); run += bl_; } while (0)
    HG_LOAD(0); HG_PREP1(); __syncthreads(); HG_PREP2(0, 0); __syncthreads();
    for (int c = 0; c < 32; ++c) {
        const int p = c & 1; const bool more = c + 1 < 32;
        if (more) HG_LOAD(c + 1);
        {
            LAS unsigned char* Bp = lds + p * BUFB; LAS bf16* QT = (LAS bf16*)Bp; LAS bf16* KP = (LAS bf16*)(Bp + OFF_KP); LAS bf16* KH = (LAS bf16*)(Bp + OFF_KH); LAS bf16* VT = (LAS bf16*)(Bp + OFF_VT);
            LAS float* DD = (LAS float*)(Bp + OFF_DD);
            f32x4 pt00 = (f32x4){0.f, 0.f, 0.f, 0.f}, pt01 = pt00, pt11 = pt00, o0 = pt00, o1 = pt00;
#pragma unroll
            for (int ks = 0; ks < 4; ++ks) {
                const bf16x8 a0 = *(const LAS bf16x8*)(KP + fr * 136 + 32 * ks + 8 * fq), a1 = *(const LAS bf16x8*)(KP + (16 + fr) * 136 + 32 * ks + 8 * fq);
                const bf16x8 b0 = *(const LAS bf16x8*)(QT + fr * 136 + 32 * ks + 8 * fq), b1 = *(const LAS bf16x8*)(QT + (16 + fr) * 136 + 32 * ks + 8 * fq);
                pt00 = __builtin_amdgcn_mfma_f32_16x16x32_bf16(a0, b0, pt00, 0, 0, 0); pt01 = __builtin_amdgcn_mfma_f32_16x16x32_bf16(a0, b1, pt01, 0, 0, 0); pt11 = __builtin_amdgcn_mfma_f32_16x16x32_bf16(a1, b1, pt11, 0, 0, 0);
            }
#pragma unroll
            for (int ks = 0; ks < 4; ++ks) {
                u32x4 sw; sw.x = cvt_pk_bf16(S[2 * ks][0], S[2 * ks][1]); sw.y = cvt_pk_bf16(S[2 * ks][2], S[2 * ks][3]); sw.z = cvt_pk_bf16(S[2 * ks + 1][0], S[2 * ks + 1][1]); sw.w = cvt_pk_bf16(S[2 * ks + 1][2], S[2 * ks + 1][3]);
                const bf16x8 sb = __builtin_bit_cast(bf16x8, sw);
                { const u32x2 e0 = *(const LAS u32x2*)(QT + fr * 136 + 32 * ks + 4 * fq), e1 = *(const LAS u32x2*)(QT + fr * 136 + 32 * ks + 16 + 4 * fq); u32x4 aw; aw.x = e0.x; aw.y = e0.y; aw.z = e1.x; aw.w = e1.y;
                  o0 = __builtin_amdgcn_mfma_f32_16x16x32_bf16(__builtin_bit_cast(bf16x8, aw), sb, o0, 0, 0, 0); }
                { const u32x2 e0 = *(const LAS u32x2*)(QT + (16 + fr) * 136 + 32 * ks + 4 * fq), e1 = *(const LAS u32x2*)(QT + (16 + fr) * 136 + 32 * ks + 16 + 4 * fq); u32x4 aw; aw.x = e0.x; aw.y = e0.y; aw.z = e1.x; aw.w = e1.y;
                  o1 = __builtin_amdgcn_mfma_f32_16x16x32_bf16(__builtin_bit_cast(bf16x8, aw), sb, o1, 0, 0, 0); }
            }
            {
#pragma unroll
                for (int r = 0; r < 4; ++r) { const bool keep = (4 * fq + r) <= fr; pt00[r] = keep ? pt00[r] : 0.f; pt11[r] = keep ? pt11[r] : 0.f; }
                u32x4 pa0; pa0.x = cvt_pk_bf16(pt00[0], pt00[1]); pa0.y = cvt_pk_bf16(pt00[2], pt00[3]); pa0.z = 0u; pa0.w = 0u;
                u32x4 pa1; pa1.x = cvt_pk_bf16(pt01[0], pt01[1]); pa1.y = cvt_pk_bf16(pt01[2], pt01[3]); pa1.z = cvt_pk_bf16(pt11[0], pt11[1]); pa1.w = cvt_pk_bf16(pt11[2], pt11[3]);
                const u32x2 v0 = *(const LAS u32x2*)(VT + (16 * wave + fr) * 40 + 4 * fq), v1 = *(const LAS u32x2*)(VT + (16 * wave + fr) * 40 + 16 + 4 * fq); u32x4 vw; vw.x = v0.x; vw.y = v0.y; vw.z = v1.x; vw.w = v1.y;
                const bf16x8 vb = __builtin_bit_cast(bf16x8, vw);
                o0 = __builtin_amdgcn_mfma_f32_16x16x32_bf16(__builtin_bit_cast(bf16x8, pa0), vb, o0, 0, 0, 0);
                o1 = __builtin_amdgcn_mfma_f32_16x16x32_bf16(__builtin_bit_cast(bf16x8, pa1), vb, o1, 0, 0, 0);
            }
#pragma unroll
            for (int r = 0; r < 4; ++r) { OB[(4 * fq + r) * 132 + 16 * wave + fr] = o0[r]; OB[(16 + 4 * fq + r) * 132 + 16 * wave + fr] = o1[r]; }
            {
                const bf16x8 vn = *(const LAS bf16x8*)(VT + (16 * wave + fr) * 40 + 8 * fq);
#pragma unroll
                for (int kt = 0; kt < 8; ++kt) { const bf16x8 ka = *(const LAS bf16x8*)(KH + (16 * kt + fr) * 40 + 8 * fq); const f32x4 dd = *(const LAS f32x4*)(DD + 16 * kt + 4 * fq);
                    S[kt] = __builtin_amdgcn_mfma_f32_16x16x32_bf16(ka, vn, S[kt] * dd, 0, 0, 0); }
            }
        }
        if (more) HG_PREP1();
        __syncthreads();
        if (more) HG_PREP2(p ^ 1, c + 1);
        {
            const f32x4 x0 = *(const LAS f32x4*)(OB + nt * 132 + nsub * 8), x1 = *(const LAS f32x4*)(OB + nt * 132 + nsub * 8 + 4);
            u32x4 r; r.x = cvt_pk_bf16(x0[0], x0[1]); r.y = cvt_pk_bf16(x0[2], x0[3]); r.z = cvt_pk_bf16(x1[0], x1[1]); r.w = cvt_pk_bf16(x1[2], x1[3]);
            *(u32x4*)(HEADS + (size_t)(b * SEQ + (c0 + c) * 32 + nt) * D + h * 128 + nsub * 8) = r;
        }
        __syncthreads();
    }
#pragma unroll
    for (int kt = 0; kt < 8; ++kt)
#pragma unroll
        for (int r = 0; r < 4; ++r) Ubuf[(size_t)unit * 16384 + (16 * kt + 4 * fq + r) * 128 + 16 * wave + fr] = S[kt][r];
    if (tq == 0) Dbuf[unit * 128 + k] = __expf(run);
#undef HG_LOAD
#undef HG_PREP1
#undef HG_PREP2
}

__device__ __forceinline__ void hgrn_fix_stage(LAS bf16* ST, const float* Ubuf, const float* Dbuf, int unit, int tid) {
    const int seg = unit & 3, bh = unit >> 2;
    if (seg > 0) {
        const int k = tid >> 2, v0 = (tid & 3) * 32;
        const float* U0 = Ubuf + (size_t)(bh * 4) * 16384 + k * 128 + v0;
        const float d1 = Dbuf[(bh * 4 + 1) * 128 + k], d2 = Dbuf[(bh * 4 + 2) * 128 + k];
#pragma unroll
        for (int i = 0; i < 8; ++i) {
            f32x4 s = *(const f32x4*)(U0 + 4 * i);
            if (seg > 1) s = s * d1 + *(const f32x4*)(U0 + 16384 + 4 * i);
            if (seg > 2) s = s * d2 + *(const f32x4*)(U0 + 2 * 16384 + 4 * i);
#pragma unroll
            for (int j = 0; j < 4; ++j) ST[(v0 + 4 * i + j) * 136 + k] = f2bf(s[j]);
        }
    }
}
__device__ __forceinline__ void hgrn_fix_block(LAS unsigned char* lds, const bf16* Q2, bf16* HEADS, const bf16* Gg, const float* Ubuf, const float* Dbuf, int blk, int tid) {
    const int lane = tid & 63, wave = __builtin_amdgcn_readfirstlane(tid >> 6), fr = lane & 15, fq = lane >> 4;
    const int u0 = (blk * 6) >> 3, u1 = (blk * 6 + 5) >> 3;
    hgrn_fix_stage((LAS bf16*)lds, Ubuf, Dbuf, u0, tid);
    if (u1 != u0) hgrn_fix_stage((LAS bf16*)lds + 128 * 136, Ubuf, Dbuf, u1, tid);
    __syncthreads();
    if (wave < 6) {
        const int sl = blk * 6 + wave, unit = sl >> 3, part = sl & 7;
        const LAS bf16* ST = (const LAS bf16*)lds + (unit != u0 ? 128 * 136 : 0);
        const int seg = unit & 3, bh = unit >> 2, h = bh % 6, b = bh / 6;
        for (int tt = 0; tt < 8; ++tt) {
            const size_t row = (size_t)b * SEQ + seg * 1024 + part * 128 + tt * 16 + fr;
            f32x4 acc[8];
#pragma unroll
            for (int vt = 0; vt < 8; ++vt) acc[vt] = (f32x4){0.f, 0.f, 0.f, 0.f};
            if (seg > 0) {
                bf16x8 qb[4];
#pragma unroll
                for (int ks = 0; ks < 4; ++ks) qb[ks] = *(const bf16x8*)(Q2 + row * DT + h * 128 + 32 * ks + 8 * fq);
#pragma unroll
                for (int vt = 0; vt < 8; ++vt)
#pragma unroll
                    for (int ks = 0; ks < 4; ++ks) { const bf16x8 a = *(const LAS bf16x8*)(ST + (16 * vt + fr) * 136 + 32 * ks + 8 * fq); acc[vt] = __builtin_amdgcn_mfma_f32_16x16x32_bf16(a, qb[ks], acc[vt], 0, 0, 0); }
            }
            float ss = 0.f;
#pragma unroll
            for (int vt = 0; vt < 8; ++vt) { const u32x2 ow = *(const u32x2*)(HEADS + row * D + h * 128 + 16 * vt + 4 * fq);
                acc[vt][0] += bflo(ow.x); acc[vt][1] += bfhi(ow.x); acc[vt][2] += bflo(ow.y); acc[vt][3] += bfhi(ow.y);
                ss += (acc[vt][0] * acc[vt][0] + acc[vt][1] * acc[vt][1]) + (acc[vt][2] * acc[vt][2] + acc[vt][3] * acc[vt][3]); }
            ss += __shfl_xor(ss, 16); ss += __shfl_xor(ss, 32);
            const float rs = rsqrtf(ss * (1.0f / 128.0f) + EPS);
#pragma unroll
            for (int vt = 0; vt < 8; ++vt) { const u32x2 gw = *(const u32x2*)(Gg + row * DT + h * 128 + 16 * vt + 4 * fq);
                u32x2 w; w.x = cvt_pk_bf16(acc[vt][0] * rs * bflo(gw.x), acc[vt][1] * rs * bfhi(gw.x)); w.y = cvt_pk_bf16(acc[vt][2] * rs * bflo(gw.y), acc[vt][3] * rs * bfhi(gw.y));
                *(u32x2*)(HEADS + row * D + h * 128 + 16 * vt + 4 * fq) = w; }
        }
    }
    __syncthreads();
}

#define XB_TMO      128
#define XB_XCNT(j)  (256  + 64 * (j))
#define XB_XSUB(j)  (1280 + 64 * (j))
#define XB_XGEN(j)  (2304 + 64 * (j))
#define XB_TOP      3328
#define XB_TOPGEN   3392
#define XCD_BAR_WORDS 3456
#define XB_SPIN_CAP (1u << 18)

__device__ __forceinline__ unsigned xb_ld(unsigned* p)              { return __hip_atomic_load(p, __ATOMIC_RELAXED, __HIP_MEMORY_SCOPE_AGENT); }
__device__ __forceinline__ unsigned xb_add(unsigned* p, unsigned v) { return __hip_atomic_fetch_add(p, v, __ATOMIC_RELAXED, __HIP_MEMORY_SCOPE_AGENT); }
__device__ __forceinline__ unsigned xb_xcc_id() { return (unsigned)__builtin_amdgcn_s_getreg((3 << 11) | 20) & 0xFu; }
#define XB_SPIN(cond, bar) do { unsigned _sp = 0; while (cond) { __builtin_amdgcn_s_sleep(1); \
    if ((++_sp & 255u) == 0u) { if (xb_ld(&(bar)[XB_TMO])) break; if (_sp > XB_SPIN_CAP) { atomicAdd(&(bar)[XB_TMO], 1u); break; } } } } while (0)

struct XcdBarrier {
    unsigned* bar; unsigned x;
    volatile LAS unsigned* st;
};

__device__ __forceinline__ XcdBarrier xcd_barrier_post(unsigned* bar, volatile LAS unsigned* st) {
    XcdBarrier b; b.bar = bar; b.x = xb_xcc_id(); b.st = st;
    if (threadIdx.x == 0) (void)xb_add(&bar[XB_XCNT(b.x)], 1u);
    return b;
}
__device__ __forceinline__ void xcd_barrier_complete(unsigned* bar, unsigned x, unsigned& nloc, unsigned& nx) {
    const unsigned G = gridDim.x * gridDim.y * gridDim.z;
    unsigned sum, cnt, mine, sp = 0u;
    for (;;) {
        sum = 0u; cnt = 0u; mine = 0u;
#pragma unroll
        for (unsigned j = 0; j < 16; ++j) { const unsigned c = xb_ld(&bar[XB_XCNT(j)]); sum += c; cnt += (c > 0u) ? 1u : 0u; mine = (j == x) ? c : mine; }
        if (sum == G) break;
        __builtin_amdgcn_s_sleep(1);
        if ((++sp & 255u) == 0u) { if (xb_ld(&bar[XB_TMO])) break; if (sp > XB_SPIN_CAP) { atomicAdd(&bar[XB_TMO], 1u); break; } }
    }
    nloc = mine > 0u ? mine : 1u; nx = cnt > 0u ? cnt : 1u;
}

__device__ __forceinline__ void xcd_barrier(const XcdBarrier& b) {
    asm volatile("s_waitcnt vmcnt(0)" ::: "memory");
    __syncthreads();
    if (threadIdx.x == 0) {
        unsigned* bar = b.bar;
        __builtin_amdgcn_s_waitcnt(0);
        unsigned nloc = b.st[0], nx = b.st[1];
        if (nloc == 0u) { xcd_barrier_complete(bar, b.x, nloc, nx); b.st[0] = nloc; b.st[1] = nx; }
        const unsigned old = xb_add(&bar[XB_XSUB(b.x)], 1u);
        const unsigned gen = old / nloc;
        if (old + 1u == (gen + 1u) * nloc) {
            __builtin_amdgcn_fence(__ATOMIC_RELEASE, "agent");
            asm volatile("s_waitcnt vmcnt(0)" ::: "memory");
            const unsigned og = xb_add(&bar[XB_TOP], 1u);
            const unsigned tg = og / nx;
            if (og + 1u == (tg + 1u) * nx) xb_add(&bar[XB_TOPGEN], 1u);
            else XB_SPIN(xb_ld(&bar[XB_TOPGEN]) == tg, bar);
            __builtin_amdgcn_fence(__ATOMIC_ACQUIRE, "agent");
            xb_add(&bar[XB_XGEN(b.x)], 1u);
            asm volatile("s_waitcnt vmcnt(0)" ::: "memory");
        } else {
            XB_SPIN(xb_ld(&bar[XB_XGEN(b.x)]) == gen, bar);
            __builtin_amdgcn_fence(__ATOMIC_ACQUIRE, "agent");
            asm volatile("s_waitcnt vmcnt(0)" ::: "memory");
        }
    }
    __syncthreads();
}


#define PHASE_BEGIN unsigned char* ws = a.ws; asm volatile("" : "+s"(ws)); int tid = threadIdx.x; asm volatile("" : "+v"(tid)); const int lane = tid & 63, wave = __builtin_amdgcn_readfirstlane(tid >> 6); (void)lane; (void)wave; (void)ws;
#define WSP(T, off) ((T*)(ws + (off)))
#define GSYNC() do { xcd_barrier(xbar); if (PROBE == 3) { xcd_barrier(xbar); xcd_barrier(xbar); xcd_barrier(xbar); } } while (0)
__global__ void __launch_bounds__(512, 2) fwd_megakernel(Args a) {
    extern __shared__ __attribute__((aligned(16))) unsigned char lds_raw[];
    LAS unsigned char* lds = (LAS unsigned char*)lds_raw;
    cg::grid_group grid = cg::this_grid();
    const int G = gridDim.x, bx = blockIdx.x;
    if (threadIdx.x < 4) ((LAS unsigned*)(lds + 131072 + 64))[threadIdx.x] = 0u;
    __syncthreads();
    XcdBarrier xbar = xcd_barrier_post((unsigned*)(a.ws + WS_BAR), (volatile LAS unsigned*)(lds + 131072 + 64));

    for (int rep_ = 0; rep_ < (PROBE == 4 ? 2 : 1); ++rep_) {
        PHASE_BEGIN
        const float* x = a.in[0]; const float* mem = a.in[1]; const float* mix_norm = a.in[2]; const float* mem_norm = a.in[3]; const float* w_mem_kv = a.in[4];
        const float* hg_w_in = a.in[6]; const float* hg_lb = a.in[7]; const float* gm_ws = a.in[12];
        bf16* WinA = WSP(bf16, WS_WINA);
        bf16* Wkv = WSP(bf16, WS_WKV); bf16* WSB = WSP(bf16, WS_WSB); float* LB = WSP(float, WS_MISC); float* SS = WSP(float, WS_PART); float* MSS = WSP(float, WS_MPART);
        bf16* MEMB = WSP(bf16, WS_MEMB); bf16* XB = WSP(bf16, WS_XB);
        LAS float* scr = (LAS float*)(lds + wave * 16384);
        const int gw = bx * 8 + wave, NGW = G * 8;
        for (int m = gw * 4; m < M; m += NGW * 4) rows_to_bf16<4>(x + (size_t)m * D, XB + (size_t)m * D, SS + m, lane);
        for (int m = gw; m < MM; m += NGW) rows_to_bf16<1>(mem + (size_t)m * D, MEMB + (size_t)m * D, MSS + m, lane);
        convert_matrix(hg_w_in, D, NA, mix_norm, WinA, false, 0, gw, NGW, scr, lane);
        convert_matrix(w_mem_kv, D, 512, mem_norm, Wkv, false, 0, gw, NGW, scr, lane);
        convert_matrix(w_mem_kv + (size_t)D * 512, D, 512, mem_norm + D, Wkv, false, 512, gw, NGW, scr, lane);
        for (int i = bx * 512 + tid; i < 4 * M; i += G * 512) SS[M + i] = 0.f;
        for (int i = bx * 512 + tid; i < 6 * 128 * 128; i += G * 512) { const int s = i & 127, t = (i >> 7) & 127; WSB[i] = f2bf(s <= t ? gm_ws[i] : 0.f); }
        if (bx == 0) for (int c = tid; c < DT; c += 512) { const float a0 = hg_lb[c], a1 = hg_lb[DT + c], a2 = hg_lb[2 * DT + c]; const float mx = fmaxf(a0, fmaxf(a1, a2));
            const float e0 = __expf(a0 - mx), e1 = __expf(a1 - mx), e2 = __expf(a2 - mx); LB[c] = e0 / (e0 + e1 + e2); }
    }
    grid.sync();

    for (int layer = 0; layer < 2; ++layer) {
        if (layer == 0) {
#ifndef SKIP_G1A
            for (int rep_ = 0; rep_ < (PROBE == 6 ? 2 : 1); ++rep_)
            { PHASE_BEGIN
              pg8::Gemm g{WSP(bf16, WS_XB), WSP(bf16, WS_WINA), M, NA, D}; RsOrder S; S.init(M, NA, G, bx); S.ss = (const GAS float*)WSP(float, WS_PART); S.pa = 0.f; S.pb = 0.f; S.nth = 0;
              EpiProjA E{&S, (LAS float*)(lds + 131072 + 1024), (GAS bf16*)WSP(bf16, WS_Q), (GAS float*)WSP(float, WS_LF), (GAS bf16*)WSP(bf16, WS_V), (GAS bf16*)WSP(bf16, WS_G), (GAS bf16*)WSP(bf16, WS_QM), (const GAS float*)WSP(float, WS_MISC), (const GAS float*)a.in[8]};
              pg8::gemm_phase<EpiProjA, RsOrder, true, true>(lds, g, S, E); }
#endif
#ifndef SKIP_KV
            { PHASE_BEGIN
              pg8::Gemm g{WSP(bf16, WS_MEMB), WSP(bf16, WS_WKV), MM, 1024, D}; RsOrder S; S.init(MM, 1024, G, (bx + 128) % G); S.ss = (const GAS float*)WSP(float, WS_MPART); S.pa = 0.f; S.pb = 0.f; S.nth = 0;
              EpiKV E{&S, (LAS float*)(lds + 131072 + 1024), (GAS bf16*)WSP(bf16, WS_KV)};
              pg8::gemm_phase<EpiKV, RsOrder, true, true>(lds, g, S, E); }
#endif
            if (bx >= 160) { PHASE_BEGIN
              convert_group(a, ws, 1, (bx - 160) * 8 + wave, (G - 160) * 8, (LAS float*)(lds + wave * 16384), lane); }
        } else {
#ifndef SKIP_G1B
            for (int rep_ = 0; rep_ < (PROBE == 7 ? 2 : 1); ++rep_) {
            PHASE_BEGIN
            pg8::Gemm g{WSP(bf16, WS_XB), WSP(bf16, WS_WINB), M, NBW, D}; RsOrder S; S.init(M, NBW, G, bx); S.ss = (const GAS float*)(WSP(float, WS_PART) + 2 * M); S.pa = 0.f; S.pb = 0.f; S.nth = 0;
            EpiProjB E{&S, (LAS float*)(lds + 131072 + 1024), (GAS bf16*)WSP(bf16, WS_Q), (GAS bf16*)WSP(bf16, WS_V), (GAS bf16*)WSP(bf16, WS_QM), (GAS float*)WSP(float, WS_LNP)};
            pg8::gemm_phase<EpiProjB, RsOrder, true, true>(lds, g, S, E); }
#endif
            if (bx >= 128) { PHASE_BEGIN
              convert_group(a, ws, 2, (bx - 128) * 8 + wave, (G - 128) * 8, (LAS float*)(lds + wave * 16384), lane); }
        }
        GSYNC();
        if (layer == 0) {
            { PHASE_BEGIN
#ifndef SKIP_HG
              if (bx < 192) hgrn_mfma_unit(lds, WSP(bf16, WS_Q), (bf16*)a.out, WSP(float, WS_LF), WSP(bf16, WS_V), WSP(bf16, WS_HEADS), WSP(float, WS_XB), WSP(float, WS_XB + 16 * MiB), bx, tid);
#endif
#ifndef SKIP_MA
              if (bx >= 192) memattn_block(lds, (const GAS bf16*)WSP(bf16, WS_QM), (const GAS bf16*)WSP(bf16, WS_KV), (GAS bf16*)WSP(bf16, WS_HEADS), 0, bx - 192, G - 192, 512, tid);
#endif
            }
            GSYNC();
            { PHASE_BEGIN
#ifndef SKIP_HG
              hgrn_fix_block(lds, (const bf16*)a.out, WSP(bf16, WS_HEADS), WSP(bf16, WS_G), WSP(float, WS_XB), WSP(float, WS_XB + 16 * MiB), bx, tid);
#endif
            }
        } else {
            PHASE_BEGIN
            for (int rep_ = 0; rep_ < (PROBE == 5 ? 2 : 1); ++rep_) {
#ifndef SKIP_GM
                gmlp_block(lds, (const GAS bf16*)WSP(bf16, WS_Q), (const GAS bf16*)WSP(bf16, WS_V), (const GAS float*)WSP(float, WS_LNP), (const GAS float*)a.in[10], (const GAS float*)a.in[11],
                           (const GAS bf16*)WSP(bf16, WS_WSB), (const GAS float*)a.in[13], (GAS bf16*)WSP(bf16, WS_HEADS), bx, G, tid);
#endif
#ifndef SKIP_MA
                memattn_block(lds, (const GAS bf16*)WSP(bf16, WS_QM), (const GAS bf16*)WSP(bf16, WS_KV), (GAS bf16*)WSP(bf16, WS_HEADS), 1, bx, G, 512, tid);
#endif
            }
        }
        GSYNC();
#ifndef SKIP_G2
        { PHASE_BEGIN
          pg8::Gemm g{WSP(bf16, WS_HEADS), WSP(bf16, WS_WOUT) + (size_t)layer * D * D, M, D, D}; pg8::StaticOrder S; S.init(M, D, G, bx);
          EpiRes E{layer == 0 ? (const GAS float*)a.in[0] : (const GAS float*)nullptr, nullptr, (GAS bf16*)WSP(bf16, WS_XB), (GAS float*)(WSP(float, WS_PART) + (size_t)(1 + 2 * layer) * M)};
          pg8::gemm_phase<EpiRes, pg8::StaticOrder, true, true>(lds, g, S, E); }
#endif
        GSYNC();
#ifndef SKIP_G3
        for (int rep_ = 0; rep_ < (PROBE == 2 ? 2 : 1); ++rep_)
        { PHASE_BEGIN
          pg8::Gemm g{WSP(bf16, WS_XB), WSP(bf16, WS_WFFI) + (size_t)layer * NF * D, M, NF, D}; RsOrder S; S.init(M, NF, G, bx); S.ss = (const GAS float*)(WSP(float, WS_PART) + (size_t)(1 + 2 * layer) * M); S.pa = 0.f; S.pb = 0.f; S.nth = 0;
          EpiFfn E{&S, (LAS float*)(lds + 131072 + 1024), (GAS bf16*)WSP(bf16, WS_ACT)};
          pg8::gemm_phase<EpiFfn, RsOrder, true, true>(lds, g, S, E); }
#endif
        GSYNC();
#ifndef SKIP_G4
        { PHASE_BEGIN
          pg8::Gemm g{WSP(bf16, WS_ACT), WSP(bf16, WS_WFFO) + (size_t)layer * D * FF, M, D, FF}; ReverseOrder S; S.initr(M, D, G, bx);
          EpiRes E{nullptr, nullptr, (GAS bf16*)WSP(bf16, WS_XB), (GAS float*)(WSP(float, WS_PART) + (size_t)(2 + 2 * layer) * M)};
          pg8::gemm_phase<EpiRes, ReverseOrder, true, true>(lds, g, S, E); }
#endif
        GSYNC();
    }
    { PHASE_BEGIN
      const float* SS4 = WSP(float, WS_PART) + (size_t)4 * M; const bf16* XB = WSP(bf16, WS_XB); float* out = a.out; const float* final_norm = a.in[17];
      const int gw = bx * 8 + wave, NGW = G * 8;
      f32x4 gn[4];
#pragma unroll
      for (int j = 0; j < 4; ++j) gn[j] = ((const f32x4*)final_norm)[(j >> 1) * 128 + 2 * lane + (j & 1)];
      for (int m = gw * 4; m < M; m += NGW * 4) {
          u32x4 w[4][2]; float rs[4];
#pragma unroll
          for (int r = 0; r < 4; ++r) { rs[r] = row_rstd(SS4, m + r);
#pragma unroll
              for (int hh = 0; hh < 2; ++hh) w[r][hh] = ((const u32x4*)(XB + (size_t)(m + r) * D))[hh * 64 + lane]; }
#pragma unroll
          for (int r = 0; r < 4; ++r)
#pragma unroll
              for (int hh = 0; hh < 2; ++hh) { f32x4* o = (f32x4*)(out + (size_t)(m + r) * D) + hh * 128 + 2 * lane;
                  o[0] = (f32x4){bflo(w[r][hh].x), bfhi(w[r][hh].x), bflo(w[r][hh].y), bfhi(w[r][hh].y)} * rs[r] * gn[2 * hh];
                  o[1] = (f32x4){bflo(w[r][hh].z), bfhi(w[r][hh].z), bflo(w[r][hh].w), bfhi(w[r][hh].w)} * rs[r] * gn[2 * hh + 1]; } } }
}

extern "C" void kernel_launch(void* const* d_in, const int* in_sizes, int n_in, void* d_out, int out_size, void* d_ws, size_t ws_size, hipStream_t stream) {
    static int grid_blocks = 0;
    if (!grid_blocks) {
        if (n_in != 18 || out_size != M * D || ws_size < WS_END) { fprintf(stderr, "kernel_launch: unexpected shapes (n_in %d out %d ws %zu, need %zu)\n", n_in, out_size, ws_size, (size_t)WS_END); grid_blocks = -1; return; }
        int dev = 0, cus = 0, per_cu = 0;
        (void)hipGetDevice(&dev); (void)hipDeviceGetAttribute(&cus, hipDeviceAttributeMultiprocessorCount, dev);
        if (hipFuncSetAttribute((const void*)fwd_megakernel, hipFuncAttributeMaxDynamicSharedMemorySize, LDS_BYTES) != hipSuccess) fprintf(stderr, "kernel_launch: hipFuncSetAttribute failed\n");
        if (hipOccupancyMaxActiveBlocksPerMultiprocessor(&per_cu, fwd_megakernel, 512, LDS_BYTES) != hipSuccess || per_cu < 1) { fprintf(stderr, "kernel_launch: occupancy query gave %d\n", per_cu); per_cu = 1; }
        if (per_cu > 1) per_cu = 1;
        grid_blocks = cus * per_cu;
    }
    if (grid_blocks < 0) return;
    Args a{};
    for (int i = 0; i < 18; ++i) a.in[i] = (const float*)d_in[i];
    a.out = (float*)d_out; a.ws = (unsigned char*)d_ws;
    void* args[] = {&a};
    if (hipMemsetAsync((char*)d_ws + WS_BAR, 0, XCD_BAR_WORDS * 4, stream) != hipSuccess) fprintf(stderr, "kernel_launch: memset of barrier words failed\n");
    hipError_t e = hipLaunchCooperativeKernel((const void*)fwd_megakernel, dim3(grid_blocks), dim3(512), args, LDS_BYTES, stream);
    if (e != hipSuccess) fprintf(stderr, "cooperative launch failed: %s (grid %d)\n", hipGetErrorString(e), grid_blocks);
}
```
